# Optimizing an MI355X kernel written in HIP

```python
import jax, jax.numpy as jnp
from jax import lax
import numpy as np

D_MODEL = 2048
BATCH = 2
SEQ = 16384
DEPTH = 2

CTX_LEN = 256
GRID_W = 64

RWKV_HEAD_DIM = 64
RWKV_W = 3 * D_MODEL // 8
RWKV_HEADS = RWKV_W // RWKV_HEAD_DIM
DECAY_LORA = 64
AAA_LORA = 64
GATE_LORA = 128
RWKV_COLS = 3 * RWKV_W + DECAY_LORA + AAA_LORA + GATE_LORA
CONV_W = D_MODEL // 4
CONV_COLS = 3 * CONV_W
RET_HEAD_DIM = 128
RET_W = D_MODEL - RWKV_W - CONV_W
RET_HEADS = RET_W // RET_HEAD_DIM
RET_COLS = 4 * RET_W
RET_CHUNK = 128
IN_COLS = RWKV_COLS + CONV_COLS + RET_COLS
D_FF = ((8 * D_MODEL // 3 + 255) // 256) * 256
ROPE_BASE = 10000.0
ROPE_PAIRS = RET_HEAD_DIM // 4
NORM_EPS = 1e-6
RWKV_GN_EPS = 64e-5

kernel_name = "hybrid_rwkv7_shortconv_retention_dit"


def _rmsnorm(x, g):
    x32 = x.astype(jnp.float32)
    return x32 * lax.rsqrt(jnp.mean(x32 * x32, axis=-1, keepdims=True) + NORM_EPS) * g


def _head_norm(y, eps):
    y = y.astype(jnp.float32)
    mu = jnp.mean(y, axis=-1, keepdims=True)
    var = jnp.mean(jnp.square(y - mu), axis=-1, keepdims=True)
    return (y - mu) * lax.rsqrt(var + eps)


def _dwconv3(z, w):
    zp = jnp.pad(z, ((0, 0), (1, 1), (0, 0)))
    return zp[:, :-2] * w[:, 0] + zp[:, 1:-1] * w[:, 1] + zp[:, 2:] * w[:, 2]


def _token_lerp(z, mu):
    zp = jnp.pad(z, ((0, 0), (1, 1), (0, 0)))
    nb = 0.5 * (zp[:, :-2] + zp[:, 2:])
    return z + (nb - z) * mu


def _axial_rope_tables(row, col):
    freqs = 1.0 / (ROPE_BASE ** (jnp.arange(ROPE_PAIRS, dtype=jnp.float32) / ROPE_PAIRS))
    ang = jnp.concatenate([row[:, None] * freqs, col[:, None] * freqs], axis=-1)
    return jnp.cos(ang), jnp.sin(ang)


def _apply_rope(u, cos, sin):
    half = RET_HEAD_DIM // 2
    u1, u2 = u[..., :half], u[..., half:]
    return jnp.concatenate([u1 * cos - u2 * sin, u1 * sin + u2 * cos], axis=-1)


def _rwkv_features(z, mu, w0, w_up, a0, a_up, g_up, k_k, k_a):
    z = _token_lerp(z, mu)
    o = 3 * RWKV_W
    r, k, v, wd, ad, gd = jnp.split(
        z, [RWKV_W, 2 * RWKV_W, o, o + DECAY_LORA, o + DECAY_LORA + AAA_LORA], axis=-1)
    b, t = z.shape[:2]
    kk = (k * k_k).reshape(b, t, RWKV_HEADS, RWKV_HEAD_DIM)
    kk = kk / jnp.maximum(jnp.sqrt(jnp.sum(kk * kk, axis=-1, keepdims=True)), 1e-12)
    kk = kk.reshape(b, t, RWKV_W)
    tw = jnp.tanh(wd)
    decays, keys, rates = [], [], []
    for d in range(2):
        w_log = -jax.nn.softplus(-(w0[d] + tw @ w_up[d])) - 0.5
        decays.append(jnp.exp(-jnp.exp(w_log)))
        a = jax.nn.sigmoid(a0[d] + ad @ a_up[d])
        rates.append(a)
        keys.append(k * (1.0 + (a - 1.0) * k_a))
    g = jax.nn.sigmoid(gd) @ g_up
    return r, v, kk, decays, keys, rates, g


def _wkv7_scan(r, w, k, v, kk, a, s0, reverse):
    b, t = r.shape[:2]

    def tm(u):
        return u.astype(jnp.float32).reshape(b, t, RWKV_HEADS, RWKV_HEAD_DIM).transpose(1, 0, 2, 3)

    xs = (tm(r), tm(w), tm(k), tm(v), tm(-kk), tm(kk * a))

    def step(s, inp):
        r_t, w_t, k_t, v_t, na_t, b_t = inp
        sa = jnp.einsum('bhij,bhj->bhi', s, na_t)
        s = s * w_t[:, :, None, :] + sa[..., None] * b_t[:, :, None, :] + v_t[..., None] * k_t[:, :, None, :]
        return s, jnp.einsum('bhij,bhj->bhi', s, r_t)

    s, ys = lax.scan(step, s0, xs, reverse=reverse)
    return ys.transpose(1, 0, 2, 3), s


def _rwkv_bi(feats, s0_f, s0_b):
    r, v, kk, decays, keys, rates, _ = feats
    y_f, s_f = _wkv7_scan(r, decays[0], keys[0], v, kk, rates[0], s0_f, False)
    y_b, s_b = _wkv7_scan(r, decays[1], keys[1], v, kk, rates[1], s0_b, True)
    return y_f + y_b, s_f, s_b


def _rwkv_out(y, feats, r_k, lnx_g, lnx_b):
    r, v, _, _, keys, _, g = feats
    b, t = r.shape[:2]
    shp = (b, t, RWKV_HEADS, RWKV_HEAD_DIM)
    k_mid = 0.5 * (keys[0] + keys[1])
    bonus = jnp.sum(r.reshape(shp) * k_mid.reshape(shp) * r_k, axis=-1, keepdims=True) * v.reshape(shp)
    out = _head_norm(y, RWKV_GN_EPS).reshape(b, t, RWKV_W) * lnx_g + lnx_b + bonus.reshape(b, t, RWKV_W)
    return out * g


def _conv_mix(z, conv_w):
    gate_b, gate_c, h = jnp.split(z, 3, axis=-1)
    return gate_b * _dwconv3(gate_c * h, conv_w)


def _ret_prepare(z, rope):
    q, k, v, g = jnp.split(z, 4, axis=-1)
    b, n = z.shape[:2]

    def heads(u):
        return u.reshape(b, n, RET_HEADS, RET_HEAD_DIM).transpose(0, 2, 1, 3)

    q, k, v = heads(q) * (RET_HEAD_DIM ** -0.5), heads(k), heads(v)
    if rope is not None:
        q, k = _apply_rope(q, *rope), _apply_rope(k, *rope)
    return q, k, v, g


def _retention_scan(q, k, v, log_gamma, r0, strict):
    b, h, n, _ = q.shape
    nc = n // RET_CHUNK

    def chunks(u):
        return u.astype(jnp.float32).reshape(b, h, nc, RET_CHUNK, u.shape[-1]).transpose(2, 0, 1, 3, 4)

    idx = jnp.arange(RET_CHUNK, dtype=jnp.float32)
    diff = idx[:, None] - idx[None, :]
    keep = diff > 0 if strict else diff >= 0
    d_in = jnp.where(keep, jnp.exp(log_gamma[:, None, None] * jnp.maximum(diff, 0.0)), 0.0)
    xi = jnp.exp(log_gamma[:, None] * (idx + 1.0))[..., None]
    zeta = jnp.exp(log_gamma[:, None] * (RET_CHUNK - 1.0 - idx))[..., None]
    g_chunk = jnp.exp(log_gamma * RET_CHUNK)[:, None, None]

    def step(r, inp):
        qi, ki, vi = inp
        s = jnp.einsum('bhnd,bhmd->bhnm', qi, ki) * d_in
        y = jnp.einsum('bhnm,bhmv->bhnv', s, vi) + jnp.einsum('bhnd,bhdv->bhnv', qi, r) * xi
        r = r * g_chunk + jnp.einsum('bhmd,bhmv->bhdv', ki * zeta, vi)
        return r, y

    r, ys = lax.scan(step, r0, (chunks(q), chunks(k), chunks(v)))
    return ys.transpose(1, 2, 0, 3, 4).reshape(b, h, n, -1), r


def _retention_bi(q, k, v, r0_f, r0_b, lg_f, lg_b):
    flip = lambda u: jnp.flip(u, axis=2)
    y_f, r_f = _retention_scan(q, k, v, lg_f, r0_f, False)
    y_b, r_b = _retention_scan(flip(q), flip(k), flip(v), lg_b, r0_b, True)
    return y_f + flip(y_b), r_f, r_b


def _ret_out(y, g, ret_norm_g):
    b, h, n, d = y.shape
    yn = _head_norm(y, NORM_EPS).transpose(0, 2, 1, 3).reshape(b, n, h * d) * ret_norm_g
    return jax.nn.silu(g) * yn


def _conv_ffn(h, up, cw, down):
    u = _dwconv3(h @ up, cw)
    gt, vl = jnp.split(u, 2, axis=-1)
    return (jax.nn.silu(gt) * vl) @ down


def setup_inputs(seed: int = 0) -> dict:
    key = jax.random.key(seed)
    ks = iter(jax.random.split(key, 32))
    f32 = jnp.float32
    L, D = DEPTH, D_MODEL

    def nrm(shape, s):
        return s * jax.random.normal(next(ks), shape, f32)

    return {
        "x": nrm((BATCH, SEQ, D), 1.0),
        "c": nrm((BATCH, D), 1.0),
        "ctx": nrm((BATCH, CTX_LEN, D), 1.0),
        "c_ctx": nrm((D,), 1.0),
        "mod_w": nrm((L, D, 6 * D), 0.3 * D ** -0.5),
        "mod_b": nrm((L, 6 * D), 0.05),
        "norm1_g": 1.0 + nrm((L, D), 0.05),
        "norm2_g": 1.0 + nrm((L, D), 0.05),
        "w_in": nrm((L, D, IN_COLS), D ** -0.5),
        "tshift_mu": jax.random.uniform(next(ks), (L, RWKV_COLS), f32),
        "w0": jax.random.uniform(next(ks), (L, 2, RWKV_W), f32, minval=-5.0, maxval=1.0),
        "w_up": nrm((L, 2, DECAY_LORA, RWKV_W), 0.5 * DECAY_LORA ** -0.5),
        "a0": nrm((L, 2, RWKV_W), 0.5),
        "a_up": nrm((L, 2, AAA_LORA, RWKV_W), 0.5 * AAA_LORA ** -0.5),
        "g_up": nrm((L, GATE_LORA, RWKV_W), GATE_LORA ** -0.5),
        "k_k": 0.85 + nrm((L, RWKV_W), 0.05),
        "k_a": 1.0 + nrm((L, RWKV_W), 0.05),
        "r_k": nrm((L, RWKV_HEADS, RWKV_HEAD_DIM), 0.1),
        "lnx_g": 1.0 + nrm((L, RWKV_W), 0.05),
        "lnx_b": nrm((L, RWKV_W), 0.02),
        "conv_w": nrm((L, CONV_W, 3), 3 ** -0.5),
        "ret_norm_g": 1.0 + nrm((L, RET_W), 0.05),
        "w_out": nrm((L, D, D), D ** -0.5),
        "ffn_up": nrm((L, D, 2 * D_FF), D ** -0.5),
        "ffn_conv": nrm((L, 2 * D_FF, 3), 3 ** -0.5),
        "ffn_down": nrm((L, D_FF, D), D_FF ** -0.5),
        "final_norm_g": 1.0 + nrm((D,), 0.05),
    }


def reference(x, c, ctx, c_ctx, mod_w, mod_b, norm1_g, norm2_g, w_in, tshift_mu, w0, w_up,
              a0, a_up, g_up, k_k, k_a, r_k, lnx_g, lnx_b, conv_w, ret_norm_g, w_out,
              ffn_up, ffn_conv, ffn_down, final_norm_g):
    f32 = jnp.float32
    bsz, n, _ = x.shape
    rows = n // GRID_W
    row = jnp.repeat(jnp.arange(rows, dtype=f32), GRID_W)
    col = jnp.tile(jnp.arange(GRID_W, dtype=f32), rows)
    rope = _axial_rope_tables(row, col)
    hidx = jnp.arange(RET_HEADS, dtype=f32)
    lg_f = jnp.log1p(-jnp.exp2(-5.0 - hidx))
    lg_b = jnp.log1p(-jnp.exp2(-5.5 - hidx))
    s_zero = jnp.zeros((bsz, RWKV_HEADS, RWKV_HEAD_DIM, RWKV_HEAD_DIM), f32)
    r_zero = jnp.zeros((bsz, RET_HEADS, RET_HEAD_DIM, RET_HEAD_DIM), f32)

    xl = x.astype(f32)
    xc = ctx.astype(f32)
    silu_c = jax.nn.silu(c.astype(f32))
    silu_cc = jax.nn.silu(c_ctx.astype(f32))
    split_at = [RWKV_COLS, RWKV_COLS + CONV_COLS]

    for l in range(DEPTH):
        last = l == DEPTH - 1
        ml = [m[:, None, :] for m in jnp.split(silu_c @ mod_w[l] + mod_b[l], 6, axis=-1)]
        mc = jnp.split(silu_cc @ mod_w[l] + mod_b[l], 6, axis=-1)
        rwkv_p = (tshift_mu[l], w0[l], w_up[l], a0[l], a_up[l], g_up[l], k_k[l], k_a[l])

        zc = (_rmsnorm(xc, norm1_g[l]) * (1.0 + mc[1]) + mc[0]) @ w_in[l]
        zl = (_rmsnorm(xl, norm1_g[l]) * (1.0 + ml[1]) + ml[0]) @ w_in[l]
        zc_rw, zc_cv, zc_rt = jnp.split(zc, split_at, axis=-1)
        zl_rw, zl_cv, zl_rt = jnp.split(zl, split_at, axis=-1)

        feats_c = _rwkv_features(zc_rw, *rwkv_p)
        yc_rw, s_f, s_b = _rwkv_bi(feats_c, s_zero, s_zero)
        feats_l = _rwkv_features(zl_rw, *rwkv_p)
        yl_rw, _, _ = _rwkv_bi(feats_l, s_f, s_b)

        qc, kc, vc, gc = _ret_prepare(zc_rt, None)
        yc_rt, r_f, r_b = _retention_bi(qc, kc, vc, r_zero, r_zero, lg_f, lg_b)
        ql, kl, vl, gl = _ret_prepare(zl_rt, rope)
        yl_rt, _, _ = _retention_bi(ql, kl, vl, r_f, r_b, lg_f, lg_b)

        mix_l = jnp.concatenate([
            _rwkv_out(yl_rw, feats_l, r_k[l], lnx_g[l], lnx_b[l]),
            _conv_mix(zl_cv, conv_w[l]),
            _ret_out(yl_rt, gl, ret_norm_g[l]),
        ], axis=-1)
        xl = xl + ml[2] * (mix_l @ w_out[l])
        xl = xl + ml[5] * _conv_ffn(_rmsnorm(xl, norm2_g[l]) * (1.0 + ml[4]) + ml[3],
                                    ffn_up[l], ffn_conv[l], ffn_down[l])

        if not last:
            mix_c = jnp.concatenate([
                _rwkv_out(yc_rw, feats_c, r_k[l], lnx_g[l], lnx_b[l]),
                _conv_mix(zc_cv, conv_w[l]),
                _ret_out(yc_rt, gc, ret_norm_g[l]),
            ], axis=-1)
            xc = xc + mc[2] * (mix_c @ w_out[l])
            xc = xc + mc[5] * _conv_ffn(_rmsnorm(xc, norm2_g[l]) * (1.0 + mc[4]) + mc[3],
                                        ffn_up[l], ffn_conv[l], ffn_down[l])

    return _rmsnorm(xl, final_norm_g).astype(x.dtype)
```

```cpp
#include <hip/hip_runtime.h>
#include <hip/hip_cooperative_groups.h>
#include <cstdio>
#include <cstdint>
namespace cg = cooperative_groups;

typedef unsigned short u16;
typedef short bf16x8 __attribute__((ext_vector_type(8)));
typedef float f32x4 __attribute__((ext_vector_type(4)));
typedef float f2 __attribute__((ext_vector_type(2)));
#define UFOR(v, n) _Pragma("unroll") for (int v = 0; v < (n); ++v)

#define DM 2048
#define TL 16384
#define CTX 256
#define ML 32768
#define MT 33280
#define RW 768
#define RWC 2560
#define CRC 4608
#define INC 7168
#define DFF 5632
#define NTHREADS 512
#define LDS_BYTES 147456

#define MIB ((size_t)1 << 20)
#define OFF_MODS ((size_t)0)
#define OFF_BAR ((size_t)524288)
#define OFF_ROPE (1 * MIB)
#define OFF_XC (9 * MIB)
#define OFF_SB (13 * MIB)
#define OFF_LORA (15 * MIB)
#define OFF_KV (17 * MIB)
#define OFF_WIN (67 * MIB)
#define OFF_WOUT (95 * MIB)
#define OFF_WUP (103 * MIB)
#define OFF_WDN (147 * MIB)
#define OFF_A (170 * MIB)
#define OFF_ZRW (301 * MIB)
#define OFF_ZCR (464 * MIB)
#define OFF_SCR (757 * MIB)
#define FEAT_SZ ((size_t)MT * RW * 2)
#define OFF_FEAT OFF_ZCR
#define OFF_Y OFF_ZRW
#define OFF_H2 OFF_ZCR
#define LORA_L 294912

struct Params {
  const float* in[27];
  float* out;
  char* ws;
};

typedef const __attribute__((address_space(4))) Params* KP;
__device__ __forceinline__ KP kp_launder(KP k) { unsigned z; asm volatile("s_mov_b32 %0, 0" : "=s"(z)); return (KP)((const __attribute__((address_space(4))) char*)__builtin_amdgcn_kernarg_segment_ptr() + z); }

extern __shared__ __attribute__((aligned(16))) char smem[];
#define LDS_BARRIER() do { asm volatile("s_waitcnt lgkmcnt(0)" ::: "memory"); __builtin_amdgcn_s_barrier(); asm volatile("" ::: "memory"); } while (0)

__device__ __forceinline__ u16 f2bf(float f) {
  unsigned u = __float_as_uint(f);
  u += 0x7fffu + ((u >> 16) & 1u);
  return (u16)(u >> 16);
}
__device__ __forceinline__ float bf2f(u16 h) { return __uint_as_float(((unsigned)h) << 16); }
__device__ __forceinline__ unsigned pk2(float a, float b) { return (unsigned)f2bf(a) | ((unsigned)f2bf(b) << 16); }
__device__ __forceinline__ float lo2f(unsigned u) { return __uint_as_float(u << 16); }
__device__ __forceinline__ float hi2f(unsigned u) { return __uint_as_float(u & 0xffff0000u); }
__device__ __forceinline__ u16 f2h(float f) { _Float16 h = (_Float16)f; return __builtin_bit_cast(u16, h); }
__device__ __forceinline__ float h2f(u16 u) { _Float16 h = __builtin_bit_cast(_Float16, u); return (float)h; }
template <int CTRL>
__device__ __forceinline__ float dppf(float v) {
  return __int_as_float(__builtin_amdgcn_mov_dpp(__float_as_int(v), CTRL, 0xf, 0xf, true));
}
__device__ __forceinline__ float red16(float v) {
  v += dppf<0xB1>(v);
  v += dppf<0x4E>(v);
  v += dppf<0x141>(v);
  v += dppf<0x140>(v);
  return v;
}
__device__ __forceinline__ float wave_sum(float v) {
  v = red16(v);
  const int iv = __float_as_int(v);
  return (__int_as_float(__builtin_amdgcn_readlane(iv, 0)) + __int_as_float(__builtin_amdgcn_readlane(iv, 16))) +
         (__int_as_float(__builtin_amdgcn_readlane(iv, 32)) + __int_as_float(__builtin_amdgcn_readlane(iv, 48)));
}
__device__ __forceinline__ int tidx() { int t = threadIdx.x; asm volatile("" : "+v"(t)); return t; }
__device__ __forceinline__ int bidx() { int t = blockIdx.x; asm volatile("" : "+s"(t)); return t; }
__device__ __forceinline__ float sigmoidf_(float x) { return 1.f / (1.f + __expf(-x)); }
__device__ __forceinline__ float siluf_(float x) { return x / (1.f + __expf(-x)); }
__device__ __forceinline__ void seqinfo(int r, int& s0, int& len, int& mrow) {
  if (r < ML) { int b = r >> 14; s0 = b << 14; len = TL; mrow = b; }
  else { int b = (r - ML) >> 8; s0 = ML + (b << 8); len = CTX; mrow = 2; }
}
__device__ __forceinline__ void unpack8(uint4 u, float* f) {
  f[0] = lo2f(u.x); f[1] = hi2f(u.x); f[2] = lo2f(u.y); f[3] = hi2f(u.y);
  f[4] = lo2f(u.z); f[5] = hi2f(u.z); f[6] = lo2f(u.w); f[7] = hi2f(u.w);
}
__device__ __forceinline__ uint4 pack8(const float* f) {
  uint4 u; u.x = pk2(f[0], f[1]); u.y = pk2(f[2], f[3]); u.z = pk2(f[4], f[5]); u.w = pk2(f[6], f[7]); return u;
}

__device__ __forceinline__ void transpose_convert(const float* __restrict__ W, int K, int N, u16* __restrict__ WT, int mode, int bfirst, int bstride) {
  const int tid_ = tidx(); const int bid_ = bidx(); (void)bid_;
  float* tile = (float*)smem;
  const int tk = K / 64, tn = N / 128, nit = tk * tn;
  const int lr = tid_ >> 5, lc = (tid_ & 31) * 4;
  float4 v[4];
  int it = bid_ - bfirst;
  if (it < 0) return;
  if (it < nit) {
    const int k0 = (it / tn) * 64, n0 = (it % tn) * 128;
    UFOR(i, 4) v[i] = *(const float4*)(W + (size_t)(k0 + lr + 16 * i) * N + n0 + lc);
  }
  while (it < nit) {
    const int k0 = (it / tn) * 64, n0 = (it % tn) * 128;
    UFOR(i, 4) { float* t = tile + (lr + 16 * i) * 129 + lc; t[0] = v[i].x; t[1] = v[i].y; t[2] = v[i].z; t[3] = v[i].w; }
    LDS_BARRIER();
    const int nx = it + bstride;
    if (nx < nit) {
      const int k1 = (nx / tn) * 64, n1 = (nx % tn) * 128;
      UFOR(i, 4) v[i] = *(const float4*)(W + (size_t)(k1 + lr + 16 * i) * N + n1 + lc);
    }
    const int n = tid_ >> 2, kc = tid_ & 3;
    float f[16];
    UFOR(i, 16) f[i] = tile[(kc * 16 + i) * 129 + n];
    const int ng = n0 + n;
    int dn = ng;
    if (mode == 1) dn = (ng < DFF) ? ((ng >> 7) * 256 + (ng & 127)) : ((((ng - DFF) >> 7) * 256) + 128 + ((ng - DFF) & 127));
    dn = (dn & ~31) | ((((dn >> 2) & 1) << 4) | (((dn >> 3) & 3) << 2) | (dn & 3));
    u16* d = WT + (size_t)dn * K + k0 + kc * 16;
    *(uint4*)d = pack8(f); *(uint4*)(d + 8) = pack8(f + 8);
    LDS_BARRIER();
    it = nx;
  }
}

__device__ __forceinline__ void phase_mods(KP p) {
  const int tid_ = tidx(); const int bid_ = bidx(); (void)bid_;
  p = kp_launder(p);
  float* sc = (float*)smem;
  float* red = sc + 3 * DM;
  float* mods = (float*)(p->ws + OFF_MODS);
  const int tid = tid_;
  for (int i = tid; i < 3 * DM; i += NTHREADS) {
    const float v = (i < 2 * DM) ? p->in[1][i] : p->in[3][i - 2 * DM];
    sc[i] = siluf_(v);
  }
  __syncthreads();
  for (int it = bid_; it < 256; it += gridDim.x) {
    const int l = it >> 7, col0 = (it & 127) * 96;
    const float* W = p->in[4] + (size_t)l * DM * 12288;
    const int kg = tid / 24, c4 = tid % 24;
    float acc[3][4] = {};
    if (kg < 21) {
#pragma unroll 8
      for (int k = kg; k < DM; k += 21) {
        const float4 w = *(const float4*)(W + (size_t)k * 12288 + col0 + c4 * 4);
        UFOR(m, 3) {
          const float s = sc[m * DM + k];
          acc[m][0] += s * w.x; acc[m][1] += s * w.y; acc[m][2] += s * w.z; acc[m][3] += s * w.w;
        }
      }
      UFOR(m, 3)
        UFOR(q, 4) red[(kg * 3 + m) * 96 + c4 * 4 + q] = acc[m][q];
    }
    __syncthreads();
    if (tid < 288) {
      const int m = tid / 96, c = tid % 96;
      float s = 0.f;
      UFOR(g, 21) s += red[(g * 3 + m) * 96 + c];
      mods[(size_t)(l * 3 + m) * 12288 + col0 + c] = s + p->in[5][(size_t)l * 12288 + col0 + c];
    }
    __syncthreads();
  }
}

__device__ __forceinline__ void phase_misc0(KP p) {
  const int tid_ = tidx(); const int bid_ = bidx(); (void)bid_;
  p = kp_launder(p);
  const int gtid = bid_ * NTHREADS + tid_, gn = gridDim.x * NTHREADS;
  float* rc = (float*)(p->ws + OFF_ROPE);
  float* rs = rc + TL * 64;
  for (int i = gtid; i < TL * 64; i += gn) {
    const int t = i >> 6, j = i & 63;
    const float fr = 1.0f / powf(10000.0f, (float)(j & 31) / 32.0f);
    const float pos = (j < 32) ? (float)(t >> 6) : (float)(t & 63);
    const float ang = pos * fr;
    rc[i] = cosf(ang); rs[i] = sinf(ang);
  }
  u16* lora = (u16*)(p->ws + OFF_LORA);
  for (int i = gtid; i < 2 * LORA_L; i += gn) {
    const int l = i / LORA_L; int r = i % LORA_L;
    float v;
    if (r < 98304) { const int d = r / 49152, q = r % 49152, ch = q >> 6, k = q & 63; v = p->in[11][((size_t)(l * 2 + d) * 64 + k) * RW + ch]; }
    else if (r < 196608) { r -= 98304; const int d = r / 49152, q = r % 49152, ch = q >> 6, k = q & 63; v = p->in[13][((size_t)(l * 2 + d) * 64 + k) * RW + ch]; }
    else { r -= 196608; const int ch = r >> 7, k = r & 127; v = p->in[14][((size_t)l * 128 + k) * RW + ch]; }
    lora[i] = f2bf(v);
  }
}

__device__ __forceinline__ void convert_win(KP p, int l, int bf, int bs) { transpose_convert(p->in[8] + (size_t)l * DM * INC, DM, INC, (u16*)(p->ws + OFF_WIN), 0, bf, bs); }
__device__ __forceinline__ void convert_wout(KP p, int l, int bf, int bs) { transpose_convert(p->in[22] + (size_t)l * DM * DM, DM, DM, (u16*)(p->ws + OFF_WOUT), 0, bf, bs); }
__device__ __forceinline__ void convert_ffn(KP p, int l, int bf, int bs) {
  transpose_convert(p->in[23] + (size_t)l * DM * 2 * DFF, DM, 2 * DFF, (u16*)(p->ws + OFF_WUP), 1, bf, bs);
  transpose_convert(p->in[25] + (size_t)l * DFF * DM, DFF, DM, (u16*)(p->ws + OFF_WDN), 0, bf, bs);
}

__device__ __forceinline__ const float* norm_src(KP p, int l, int which, int r) {
  if (r < ML) return ((l == 0 && which == 0) ? p->in[0] : p->out) + (size_t)r * DM;
  return ((l == 0 && which == 0) ? p->in[2] : (const float*)(p->ws + OFF_XC)) + (size_t)(r - ML) * DM;
}
__device__ __forceinline__ void phase_norm(KP p, int l, int which, int nrows) {
  const int tid_ = tidx(); const int bid_ = bidx(); (void)bid_;
  p = kp_launder(p);
  const float* mods = (const float*)(p->ws + OFF_MODS) + (size_t)l * 3 * 12288;
  const float* g = p->in[which ? 7 : 6] + (size_t)l * DM;
  u16* A = (u16*)(p->ws + OFF_A);
  const int lane = tid_ & 63, wv = tid_ >> 6;
  const int sh = which ? 3 : 0, scl = which ? 4 : 1;
  const int stride = gridDim.x * 8;
  float4 va[8], vb[8];
#define NORM_LOAD(V, R_) { const float* s = norm_src(p, l, which, (R_)); UFOR(j, 8) V[j] = *(const float4*)(s + j * 256 + lane * 4); \
    if (l == 1 && which == 0 && (R_) >= ML) {     \
      const float* gt5 = (const float*)(p->ws + OFF_MODS) + (size_t)2 * 12288 + 5 * DM; \
      const float* pp = (const float*)(p->ws + (832 * MIB)) + (size_t)((R_) - ML) * DM; \
      UFOR(j, 8) { \
        const int c = j * 256 + lane * 4; \
        float4 acc4 = make_float4(0.f, 0.f, 0.f, 0.f); \
        for (int pt_ = 0; pt_ < 11; ++pt_) { const float4 q = *(const float4*)(pp + (size_t)pt_ * 512 * DM + c); acc4.x += q.x; acc4.y += q.y; acc4.z += q.z; acc4.w += q.w; } \
        const float4 g5 = *(const float4*)(gt5 + c); \
        V[j].x += g5.x * acc4.x; V[j].y += g5.y * acc4.y; V[j].z += g5.z * acc4.z; V[j].w += g5.w * acc4.w; } } }
#define NORM_BODY(V, R_) { \
    const int rr = (R_); const int mrow = rr < ML ? (rr >> 14) : 2; \
    float ss = 0.f; \
    UFOR(j, 8) ss += V[j].x * V[j].x + V[j].y * V[j].y + V[j].z * V[j].z + V[j].w * V[j].w; \
    ss = wave_sum(ss); \
    const float rstd = rsqrtf(ss * (1.0f / DM) + 1e-6f); \
    const float* ms = mods + (size_t)mrow * 12288; \
    UFOR(j, 8) { \
      const int c = j * 256 + lane * 4; \
      const float4 gg = *(const float4*)(g + c); \
      const float4 s1 = *(const float4*)(ms + scl * DM + c); \
      const float4 s0 = *(const float4*)(ms + sh * DM + c); \
      const float a = V[j].x * rstd * gg.x * (1.f + s1.x) + s0.x; \
      const float b = V[j].y * rstd * gg.y * (1.f + s1.y) + s0.y; \
      const float cc = V[j].z * rstd * gg.z * (1.f + s1.z) + s0.z; \
      const float d = V[j].w * rstd * gg.w * (1.f + s1.w) + s0.w; \
      uint2 o; o.x = pk2(a, b); o.y = pk2(cc, d); \
      *(uint2*)(A + (size_t)rr * DM + c) = o; } }
  int r = bid_ * 8 + wv;
  if (r < nrows) NORM_LOAD(va, r);
  for (; r < nrows; r += 2 * stride) {
    if (r + stride < nrows) NORM_LOAD(vb, r + stride);
    NORM_BODY(va, r);
    if (r + 2 * stride < nrows) NORM_LOAD(va, r + 2 * stride);
    if (r + stride < nrows) NORM_BODY(vb, r + stride);
  }
#undef NORM_LOAD
#undef NORM_BODY
}

__device__ __forceinline__ void phase_final(KP p) {
  const int tid_ = tidx(); const int bid_ = bidx(); (void)bid_;
  p = kp_launder(p);
  const float* g = p->in[26];
  const int lane = tid_ & 63, wv = tid_ >> 6;
  const int stride = gridDim.x * 8;
  float4 va[8], vb[8];
#define FIN_LOAD(V, R_) { const float* s = p->out + (size_t)(R_) * DM; UFOR(j, 8) V[j] = *(const float4*)(s + j * 256 + lane * 4); }
#define FIN_BODY(V, R_) { \
    float* src = p->out + (size_t)(R_) * DM; \
    float ss = 0.f; \
    UFOR(j, 8) ss += V[j].x * V[j].x + V[j].y * V[j].y + V[j].z * V[j].z + V[j].w * V[j].w; \
    ss = wave_sum(ss); \
    const float rstd = rsqrtf(ss * (1.0f / DM) + 1e-6f); \
    UFOR(j, 8) { \
      const int c = j * 256 + lane * 4; \
      const float4 gg = *(const float4*)(g + c); \
      float4 o; o.x = V[j].x * rstd * gg.x; o.y = V[j].y * rstd * gg.y; o.z = V[j].z * rstd * gg.z; o.w = V[j].w * rstd * gg.w; \
      *(float4*)(src + c) = o; } }
  int r = bid_ * 8 + wv;
  if (r < ML) FIN_LOAD(va, r);
  for (; r < ML; r += 2 * stride) {
    if (r + stride < ML) FIN_LOAD(vb, r + stride);
    FIN_BODY(va, r);
    if (r + 2 * stride < ML) FIN_LOAD(va, r + 2 * stride);
    if (r + stride < ML) FIN_BODY(vb, r + stride);
  }
#undef FIN_LOAD
#undef FIN_BODY
}

constexpr int BM = 256, BK = 64, HALF = 128, NXCD = 8, WGM = 8, HT = HALF * BK;
__device__ __forceinline__ int lds_byte(int r, int c) {
  int st = (r >> 4) * 2 + (c >> 5), rr = r & 15, cc = c & 31, ob = rr * 64 + cc * 2;
  return st * 1024 + (ob ^ (((ob >> 9) & 1) << 5));
}
__device__ __forceinline__ void stage_rc(int b, int& R, int& C) {
  int st = b / 1024, sb = b % 1024, swz = sb ^ (((sb >> 9) & 1) << 5);
  R = (st >> 1) * 16 + swz / 64; C = (st & 1) * 32 + (swz % 64) / 2;
}

enum { EPI_Z = 0, EPI_RES = 1, EPI_UPG = 2, EPI_PART = 3 };
struct EpiArgs {
  u16* zrw; u16* zcr;
  const float* srcL; const float* srcC; float* dstL; float* dstC; const float* gate;
  u16* h2; const float* cw;
  float* part;
};

template <int EPI, int K, int KL>
__device__ __forceinline__ void gemm_tile(const u16* __restrict__ A, const u16* __restrict__ Bt, const long brow, const int bcol,
                          const int pn, const int seq0, const int seq1, const EpiArgs& e,
                          const bool own_prologue, const bool has_next, const long nbrow, const int nbcol) {
  const int tid_ = tidx(); const int bid_ = bidx(); (void)bid_;
  u16* shm = (u16*)smem;
#define SA(b, h) (shm + ((b) * 2 + (h)) * HT)
#define SB(b, h) (shm + (4 + (b) * 2 + (h)) * HT)
#define STAGE(P, BASE, br, kt) STAGET(tid_, P, BASE, br, kt)
#define STAGET(TT, P, BASE, br, kt)                                                                              \
  do {                                                                                                      \
    long _g = (long)(br) * K + (long)(kt) * BK;                                                             \
    UFOR(_i, 2) {                                                                        \
      int _b = (TT) * 16 + _i * 8192; int _r, _c; stage_rc(_b, _r, _c);                              \
      __builtin_amdgcn_global_load_lds((const unsigned*)(BASE + _g + (long)_r * K + _c),                    \
                                       (__attribute__((address_space(3))) unsigned*)((char*)(P) + _b), 16, 0, 0); \
    }                                                                                                       \
  } while (0)
#define LDA(dst, b, h) UFOR(m, 4) UFOR(k, 2) \
    dst[m][k] = *reinterpret_cast<const bf16x8*>((char*)SA(b, h) + lds_byte(wr * 64 + m * 16 + fr, k * 32 + fq * 8))
#define LDB(dst, b, h) UFOR(n, 2) UFOR(k, 2) \
    dst[n][k] = *reinterpret_cast<const bf16x8*>((char*)SB(b, h) + lds_byte(wc * 32 + n * 16 + fr, k * 32 + fq * 8))
#define MMA(ai, bj, At, Bq) do { __builtin_amdgcn_s_setprio(1); \
    UFOR(m, 4) UFOR(n, 2) UFOR(k, 2) \
      acc[ai][bj][m][n] = __builtin_amdgcn_mfma_f32_16x16x32_bf16(Bq[n][k], At[m][k], acc[ai][bj][m][n], 0, 0, 0); \
    __builtin_amdgcn_s_setprio(0); } while (0)
#define WAIT_V(n) asm volatile("s_waitcnt vmcnt(" #n ")" ::: "memory")
#define WAIT_L(n) asm volatile("s_waitcnt lgkmcnt(" #n ")" ::: "memory")
#define BAR __builtin_amdgcn_s_barrier()
#define SCHED __builtin_amdgcn_sched_barrier(0)
  const int wid = tid_ >> 6, lane = tid_ & 63, wr = wid >> 2, wc = wid & 3, fr = lane & 15, fq = lane >> 4;
  f32x4 acc[2][2][4][2] = {};
  bf16x8 At[4][2], B0[2][2], B1[2][2];
  const int nt = KL / BK;
  if (own_prologue) {
    STAGE(SB(0, 0), Bt, bcol, 0); STAGE(SA(0, 0), A, brow, 0);
    STAGE(SB(0, 1), Bt, bcol + HALF, 0); STAGE(SA(0, 1), A, brow + HALF, 0);
  }
  if (wr == 1) BAR;
  WAIT_V(4); BAR;
  STAGE(SB(1, 0), Bt, bcol, 1); STAGE(SA(1, 0), A, brow, 1); STAGE(SB(1, 1), Bt, bcol + HALF, 1);
  WAIT_V(6); BAR;
  for (int t = 0; t < nt - 2; t += 2) {
    LDB(B0, 0, 0); SCHED; LDA(At, 0, 0); STAGE(SA(1, 1), A, brow + HALF, t + 1);
    WAIT_L(8); BAR; WAIT_L(0); MMA(0, 0, At, B0); BAR; SCHED;
    LDB(B1, 0, 1); STAGE(SB(0, 0), Bt, bcol, t + 2);
    BAR; WAIT_L(0); MMA(0, 1, At, B1); BAR;
    LDA(At, 0, 1); STAGE(SA(0, 0), A, brow, t + 2);
    BAR; WAIT_L(0); MMA(1, 0, At, B0); BAR; SCHED;
    STAGE(SB(0, 1), Bt, bcol + HALF, t + 2);
    WAIT_V(6); BAR; MMA(1, 1, At, B1); BAR;
    LDB(B0, 1, 0); SCHED; LDA(At, 1, 0); STAGE(SA(0, 1), A, brow + HALF, t + 2);
    WAIT_L(8); BAR; WAIT_L(0); MMA(0, 0, At, B0); BAR; SCHED;
    LDB(B1, 1, 1); STAGE(SB(1, 0), Bt, bcol, t + 3);
    BAR; WAIT_L(0); MMA(0, 1, At, B1); BAR;
    LDA(At, 1, 1); STAGE(SA(1, 0), A, brow, t + 3);
    BAR; WAIT_L(0); MMA(1, 0, At, B0); BAR; SCHED;
    STAGE(SB(1, 1), Bt, bcol + HALF, t + 3);
    WAIT_V(6); BAR; MMA(1, 1, At, B1); BAR;
  }
  { LDB(B0, 0, 0); LDA(At, 0, 0); STAGE(SA(1, 1), A, brow + HALF, nt - 1);
    BAR; WAIT_L(0); MMA(0, 0, At, B0); BAR;
    LDB(B1, 0, 1); BAR; WAIT_L(0); MMA(0, 1, At, B1); BAR;
    LDA(At, 0, 1); WAIT_V(4); BAR; WAIT_L(0); MMA(1, 0, At, B0); MMA(1, 1, At, B1); BAR; }
  { LDB(B0, 1, 0); LDA(At, 1, 0); WAIT_V(2); BAR; WAIT_L(0); MMA(0, 0, At, B0); BAR;
    LDB(B1, 1, 1); WAIT_V(0); BAR; WAIT_L(0); MMA(0, 1, At, B1); BAR;
    LDA(At, 1, 1); BAR; WAIT_L(0); MMA(1, 0, At, B0); MMA(1, 1, At, B1); BAR; }
  if (wr == 0) BAR;
  if (EPI != EPI_UPG && EPI != EPI_PART && has_next) {
    int t2 = tid_; asm volatile("" : "+v"(t2));
    STAGET(t2, SB(0, 0), Bt, nbcol, 0); STAGET(t2, SA(0, 0), A, nbrow, 0);
    STAGET(t2, SB(0, 1), Bt, nbcol + HALF, 0); STAGET(t2, SA(0, 1), A, nbrow + HALF, 0);
  }
  if (EPI == EPI_Z) {
    u16* dst; int ld, c0;
    if (bcol < RWC) { dst = e.zrw; ld = RWC; c0 = bcol; } else { dst = e.zcr; ld = CRC; c0 = bcol - RWC; }
    UFOR(ai, 2) UFOR(bj, 2) UFOR(m, 4) {
      const f32x4 a = acc[ai][bj][m][0], b = acc[ai][bj][m][1];
      uint4 pk; pk.x = pk2(a[0], a[1]); pk.y = pk2(a[2], a[3]); pk.z = pk2(b[0], b[1]); pk.w = pk2(b[2], b[3]);
      *(uint4*)(dst + (size_t)(brow + ai * HALF + wr * 64 + m * 16 + fr) * ld + (c0 + bj * HALF + wc * 32 + fq * 8)) = pk;
    }
  } else if (EPI == EPI_RES) {
    const float* src; float* dst; const float* gt; long r0 = brow;
    if (brow < ML) { src = e.srcL; dst = e.dstL; gt = e.gate + (size_t)(brow >> 14) * 12288; }
    else { src = e.srcC; dst = e.dstC; gt = e.gate + (size_t)2 * 12288; r0 = brow - ML; }
    UFOR(bj, 2) UFOR(n, 2) {
      const int c = bcol + bj * HALF + wc * 32 + fq * 8 + n * 4;
      const float4 gv = *(const float4*)(gt + c);
      UFOR(ai, 2) {
        UFOR(m, 4) {
          const size_t idx = (size_t)(r0 + ai * HALF + wr * 64 + m * 16 + fr) * DM + c;
          float4 s = *(const float4*)(src + idx);
          const f32x4 a = acc[ai][bj][m][n];
          s.x += gv.x * a[0]; s.y += gv.y * a[1]; s.z += gv.z * a[2]; s.w += gv.w * a[3];
          *(float4*)(dst + idx) = s;
        }
        __builtin_amdgcn_sched_barrier(0);
      }
    }
  } else if (EPI == EPI_PART) {
    const long r0 = brow - ML;
    UFOR(ai, 2) UFOR(bj, 2) UFOR(m, 4) UFOR(n, 2) {
      const f32x4 a = acc[ai][bj][m][n];
      *(float4*)(e.part + (size_t)(r0 + ai * HALF + wr * 64 + m * 16 + fr) * DM + (bcol + bj * HALF + wc * 32 + fq * 8 + n * 4)) = make_float4(a[0], a[1], a[2], a[3]);
    }
  } else {
    u16* U = (u16*)smem;
    LDS_BARRIER();
    UFOR(ai, 2) UFOR(bj, 2) UFOR(m, 4) {
      const f32x4 a = acc[ai][bj][m][0], b = acc[ai][bj][m][1];
      uint4 pk; pk.x = pk2(a[0], a[1]); pk.y = pk2(a[2], a[3]); pk.z = pk2(b[0], b[1]); pk.w = pk2(b[2], b[3]);
      *(uint4*)(U + (ai * HALF + wr * 64 + m * 16 + fr) * 256 + bj * 128 + wc * 32 + fq * 8) = pk;
    }
    LDS_BARRIER();
    {
      const int c4 = (tid_ & 31) * 4, rb = tid_ >> 5;
      const int gc = pn * 128 + c4;
      float wg[4][3], wv[4][3];
      UFOR(q, 4) UFOR(x, 3) { wg[q][x] = e.cw[(size_t)(gc + q) * 3 + x]; wv[q][x] = e.cw[(size_t)(DFF + gc + q) * 3 + x]; }
      float pg[4], cgv[4], ng[4], pvv[4], cv[4], nv[4];
      const int lr0 = rb * 16;
      {
        const int lrp = lr0 > 0 ? lr0 - 1 : 0;
        const uint2 a = *(const uint2*)(U + lrp * 256 + c4), b = *(const uint2*)(U + lrp * 256 + 128 + c4);
        pg[0] = lo2f(a.x); pg[1] = hi2f(a.x); pg[2] = lo2f(a.y); pg[3] = hi2f(a.y);
        pvv[0] = lo2f(b.x); pvv[1] = hi2f(b.x); pvv[2] = lo2f(b.y); pvv[3] = hi2f(b.y);
        const uint2 c = *(const uint2*)(U + lr0 * 256 + c4), d = *(const uint2*)(U + lr0 * 256 + 128 + c4);
        cgv[0] = lo2f(c.x); cgv[1] = hi2f(c.x); cgv[2] = lo2f(c.y); cgv[3] = hi2f(c.y);
        cv[0] = lo2f(d.x); cv[1] = hi2f(d.x); cv[2] = lo2f(d.y); cv[3] = hi2f(d.y);
      }
#pragma unroll 2
      for (int q = 0; q < 16; ++q) {
        const int lr = lr0 + q;
        const int lrn = lr < 255 ? lr + 1 : 255;
        const uint2 a = *(const uint2*)(U + lrn * 256 + c4), b = *(const uint2*)(U + lrn * 256 + 128 + c4);
        ng[0] = lo2f(a.x); ng[1] = hi2f(a.x); ng[2] = lo2f(a.y); ng[3] = hi2f(a.y);
        nv[0] = lo2f(b.x); nv[1] = hi2f(b.x); nv[2] = lo2f(b.y); nv[3] = hi2f(b.y);
        const long gr = brow + lr;
        const bool valid = (gr >= seq0) && (gr < seq1) && (lr >= 1 || gr == seq0) && (lr <= 254 || gr == seq1 - 1);
        if (valid) {
          const float mp = (gr - 1 >= seq0) ? 1.f : 0.f, mn = (gr + 1 < seq1) ? 1.f : 0.f;
          float o[4];
          UFOR(x, 4) {
            const float g = wg[x][0] * pg[x] * mp + wg[x][1] * cgv[x] + wg[x][2] * ng[x] * mn;
            const float v = wv[x][0] * pvv[x] * mp + wv[x][1] * cv[x] + wv[x][2] * nv[x] * mn;
            o[x] = siluf_(g) * v;
          }
          uint2 pk; pk.x = pk2(o[0], o[1]); pk.y = pk2(o[2], o[3]);
          *(uint2*)(e.h2 + (size_t)gr * DFF + gc) = pk;
        }
        UFOR(x, 4) { pg[x] = cgv[x]; cgv[x] = ng[x]; pvv[x] = cv[x]; cv[x] = nv[x]; }
      }
    }
    LDS_BARRIER();
    if (has_next) {
      int t2 = tid_; asm volatile("" : "+v"(t2));
      STAGET(t2, SB(0, 0), Bt, nbcol, 0); STAGET(t2, SA(0, 0), A, nbrow, 0);
      STAGET(t2, SB(0, 1), Bt, nbcol + HALF, 0); STAGET(t2, SA(0, 1), A, nbrow + HALF, 0);
    }
  }
#undef SA
#undef SB
}

template <int EPI>
__device__ __forceinline__ void tile_coords(int L, int nM, int nN, long& brow, int& pn, int& seq0, int& seq1) {
  const int nwg = nM * nN;
  int wgid = L;
  { const int q = nwg / NXCD, r = nwg % NXCD, xcd = wgid % NXCD, off = wgid / NXCD; wgid = (xcd < r ? xcd * (q + 1) : r * (q + 1) + (xcd - r) * q) + off; }
  const int nig = WGM * nN, gid = wgid / nig, fm = gid * WGM, gsz = (nM - fm) < WGM ? (nM - fm) : WGM;
  const int pm = fm + ((wgid % nig) % gsz);
  pn = (wgid % nig) / gsz;
  seq0 = 0; seq1 = 0;
  if (EPI == EPI_UPG) {
    if (pm < 130) { const int s = pm / 65, i = pm % 65; seq0 = s * TL; seq1 = seq0 + TL; brow = seq0 + 254 * i - 1; }
    else { const int s = pm - 130; seq0 = ML + s * CTX; seq1 = seq0 + CTX; brow = seq0; }
  } else brow = (long)pm * BM;
}
template <int EPI, int K>
__device__ __forceinline__ void gemm_phase(const u16* A, const u16* Bt, int nM, int nN, const EpiArgs& e) {
  const int tid_ = tidx(); const int bid_ = bidx(); (void)bid_; (void)tid_;
  const int nwg = nM * nN, G = gridDim.x;
  long brow = 0, nbrow = 0; int pn = 0, seq0 = 0, seq1 = 0, npn = 0, nseq0 = 0, nseq1 = 0;
  if (bid_ < nwg) tile_coords<EPI>(bid_, nM, nN, brow, pn, seq0, seq1);
  bool first = true;
  for (int L = bid_; L < nwg; L += G) {
    const bool has_next = (L + G) < nwg;
    if (has_next) tile_coords<EPI>(L + G, nM, nN, nbrow, npn, nseq0, nseq1);
    gemm_tile<EPI, K, K>(A, Bt, brow, pn * BM, pn, seq0, seq1, e, first, has_next, nbrow, npn * BM);
    first = false;
    brow = nbrow; pn = npn; seq0 = nseq0; seq1 = nseq1;
  }
  __syncthreads();
}

#define OFF_P2 (832 * MIB)
#define P2_PARTS 11
__device__ __forceinline__ void gemm_ctx_splitk_down(const u16* A, const u16* Bt, float* P2, const EpiArgs& e0) {
  const int tid_ = tidx(); const int bid_ = bidx(); (void)tid_;
  for (int u = bid_; u < 16 * P2_PARTS; u += gridDim.x) {
    const int tile = u / P2_PARTS, part = u % P2_PARTS, pm = 128 + (tile >> 3), pn = tile & 7;
    EpiArgs e = e0; e.part = P2 + (size_t)part * 512 * DM;
    const long koff = (long)part * (DFF / P2_PARTS);
    gemm_tile<EPI_PART, DFF, DFF / P2_PARTS>(A + koff, Bt + koff, (long)pm * BM, pn * BM, pn, 0, 0, e, true, false, 0, 0);
  }
  __syncthreads();
}

#define R_QS 0
#define R_KS 17408
#define R_KT 34816
#define R_VT 53248
#define R_SS 71680
#define R_RT 80896
#define R_KT2 34816
#define R_KT2B 71680
__device__ __forceinline__ float lg_gamma(int h, int dir) { return log1pf(-exp2f(-(dir ? 5.5f : 5.0f) - (float)h)); }

__device__ __forceinline__ bf16x8 ldsfrag(int base, int row, int ldb, int kel) {
  return *(const bf16x8*)(smem + base + row * ldb + kel * 2);
}
#define MFMA16(a, b, c) __builtin_amdgcn_mfma_f32_16x16x32_bf16(a, b, c, 0, 0, 0)
__device__ __forceinline__ bf16x8 ldsfrag_sw(int base, int row, int ks, int fq) {
  return *(const bf16x8*)(smem + base + row * 144 + ((((ks << 2) | fq) ^ ((row >> 3) & 7)) << 4));
}
#define LDSFRAG_SWN(base, N, ks, pl0, pl1, rowoff) \
  (*(const bf16x8*)(smem + (base) + (rowoff) + (N) * 2304 + ((((ks) ^ (((N) >> 1) & 1)) << 6)) + (((N) & 1) ? (pl1) : (pl0))))

#define R_TAB 115712
struct RetRaw { uint4 q1, q2, k1, k2, v1, v2; float4 c0, c1, s0, s1; };
__device__ __forceinline__ void ret_issue(KP p, RetRaw& R, int tid_, int mode, int base, int rev, int h, int rope, int t0) {
  const u16* zcr = (const u16*)(p->ws + OFF_ZCR);
  const float* rc = (const float*)(p->ws + OFF_ROPE);
  const float* rs = rc + TL * 64;
  const int i = tid_ >> 3, g = tid_ & 7;
  const int nr = rev ? (base + 63 - i) : (base + i);
  const u16* zr = zcr + (size_t)nr * CRC + 1536 + h * 128;
  R.k1 = *(const uint4*)(zr + 768 + g * 8); R.k2 = *(const uint4*)(zr + 768 + 64 + g * 8);
  R.v1 = *(const uint4*)(zr + 1536 + g * 8); R.v2 = *(const uint4*)(zr + 1536 + 64 + g * 8);
  if (mode == 0) { R.q1 = *(const uint4*)(zr + g * 8); R.q2 = *(const uint4*)(zr + 64 + g * 8); }
  if (rope) {
    const int t = t0 + (rev ? (63 - i) : i);
    const float* cp = rc + (size_t)t * 64 + g * 8; const float* sp = rs + (size_t)t * 64 + g * 8;
    R.c0 = *(const float4*)cp; R.c1 = *(const float4*)(cp + 4); R.s0 = *(const float4*)sp; R.s1 = *(const float4*)(sp + 4);
  }
}
__device__ __forceinline__ void ret_stage(const RetRaw& R, int tid_, int mode, int rope, float zf, float zb) {
  const int i = tid_ >> 3, g = tid_ & 7;
  float q1[8], q2[8], k1[8], k2[8], v1[8], v2[8];
  unpack8(R.k1, k1); unpack8(R.k2, k2); unpack8(R.v1, v1); unpack8(R.v2, v2);
  if (mode == 0) { unpack8(R.q1, q1); unpack8(R.q2, q2); }
  if (rope) {
    const float cc[8] = {R.c0.x, R.c0.y, R.c0.z, R.c0.w, R.c1.x, R.c1.y, R.c1.z, R.c1.w};
    const float ss[8] = {R.s0.x, R.s0.y, R.s0.z, R.s0.w, R.s1.x, R.s1.y, R.s1.z, R.s1.w};
    UFOR(x, 8) {
      const float c = cc[x], s = ss[x];
      const float a = k1[x], b = k2[x]; k1[x] = a * c - b * s; k2[x] = a * s + b * c;
      if (mode == 0) { const float a2 = q1[x], b2 = q2[x]; q1[x] = a2 * c - b2 * s; q2[x] = a2 * s + b2 * c; }
    }
  }
  u16* VT = (u16*)(smem + R_VT);
  const int isw = i ^ (g << 3);
  UFOR(x, 8) { VT[(g * 8 + x) * 72 + isw] = f2bf(v1[x]); VT[(64 + g * 8 + x) * 72 + isw] = f2bf(v2[x]); }
  u16* KT = (u16*)(smem + R_KT);
  UFOR(x, 8) { KT[(g * 8 + x) * 72 + isw] = f2bf(k1[x] * zf); KT[(64 + g * 8 + x) * 72 + isw] = f2bf(k2[x] * zf); }
  if (mode == 1) {
    u16* KB = (u16*)(smem + R_KT2B);
    UFOR(x, 8) { KB[(g * 8 + x) * 72 + isw] = f2bf(k1[x] * zb); KB[(64 + g * 8 + x) * 72 + isw] = f2bf(k2[x] * zb); }
  } else {
    const float sc = 0.08838834764831845f;
    UFOR(x, 8) { q1[x] *= sc; q2[x] *= sc; }
    *(uint4*)(smem + R_QS + i * 272 + g * 16) = pack8(q1); *(uint4*)(smem + R_QS + i * 272 + 128 + g * 16) = pack8(q2);
    *(uint4*)(smem + R_KS + i * 272 + g * 16) = pack8(k1); *(uint4*)(smem + R_KS + i * 272 + 128 + g * 16) = pack8(k2);
  }
}

#define NSEG 21
__device__ __forceinline__ int seg_c0(int s) { return (s * 256) / NSEG; }
__device__ __forceinline__ void phase_ret_summaries(KP p) {
  const int tid_ = tidx(); const int bid_ = bidx(); (void)bid_;
  p = kp_launder(p);
  float* KV = (float*)(p->ws + OFF_KV);
  const int lane = tid_ & 63, w = tid_ >> 6, fr = lane & 15, fq = lane >> 4;
  const int ti = tid_ >> 3;
  const int pl0 = fr * 144 + ((fq ^ (fr >> 3)) << 4), pl1 = fr * 144 + (((fq ^ (fr >> 3)) ^ 2) << 4);
  int it_step = gridDim.x;
  if ((int)gridDim.x > 12 * NSEG) it_step = (bid_ >= 12 * NSEG) ? ((int)gridDim.x - 12 * NSEG) : 12 * (NSEG + 1);
  for (int it = bid_; it < 12 * (NSEG + 1); it += it_step) {
    int bh, seg;
    if (it < 12 * NSEG) { bh = it / NSEG; seg = it % NSEG; } else { bh = it - 12 * NSEG; seg = NSEG; }
    const int b = bh / 6, h = bh % 6;
    const int isctx = seg == NSEG;
    const int c0 = seg_c0(seg), tseg0 = c0 * 64;
    const int L = isctx ? CTX : (seg_c0(seg + 1) - c0) * 64;
    const int n0 = isctx ? (ML + b * CTX) : (b * TL + tseg0);
    const float lgf = lg_gamma(h, 0), lgb = lg_gamma(h, 1);
    f32x4 af[8], ab[8];
    UFOR(n, 8) { af[n] = (f32x4){0.f, 0.f, 0.f, 0.f}; ab[n] = af[n]; }
    RetRaw R;
    ret_issue(p, R, tid_, 1, n0, 0, h, !isctx, tseg0);
    const int nsc = L / 64;
    for (int sc = 0; sc < nsc; ++sc) {
      LDS_BARRIER();
      ret_stage(R, tid_, 1, !isctx, expf(lgf * (float)(L - 1 - sc * 64 - ti)), expf(lgb * (float)(sc * 64 + ti)));
      if (sc + 1 < nsc) ret_issue(p, R, tid_, 1, n0 + (sc + 1) * 64, 0, h, !isctx, tseg0 + (sc + 1) * 64);
      LDS_BARRIER();
      UFOR(ks, 2) {
        const bf16x8 a = ldsfrag_sw(R_VT, w * 16 + fr, ks, fq);
        UFOR(n, 8) {
          af[n] = MFMA16(LDSFRAG_SWN(R_KT, n, ks, pl0, pl1, 0), a, af[n]);
          ab[n] = MFMA16(LDSFRAG_SWN(R_KT2B, n, ks, pl0, pl1, 0), a, ab[n]);
        }
      }
    }
    f32x4* of = (f32x4*)(KV + (((size_t)(bh * 2 + 0) * (NSEG + 1) + seg) * 512 + tid_) * 32);
    f32x4* ob = (f32x4*)(KV + (((size_t)(bh * 2 + 1) * (NSEG + 1) + seg) * 512 + tid_) * 32);
    UFOR(n, 8) { of[n] = af[n]; ob[n] = ab[n]; }
  }
}

__device__ __forceinline__ void ret_pass(KP p, int tid_, int dir, int n0, int nch, int h, int rope, int tseg0, f32x4* RT, float* scr) {
  const int lane = tid_ & 63, w = tid_ >> 6, fr = lane & 15, fq = lane >> 4;
  const int mt = w >> 1, nh = w & 1;
  const int pl0 = fr * 144 + ((fq ^ (fr >> 3)) << 4), pl1 = fr * 144 + (((fq ^ (fr >> 3)) ^ 2) << 4);
  const float* pw = (const float*)(smem + R_TAB) + dir * 65;
  const float g64 = pw[64];
  RetRaw R;
  { const int nc0 = dir ? (nch - 1) : 0; ret_issue(p, R, tid_, 0, n0 + nc0 * 64, dir, h, rope, tseg0 + nc0 * 64); }
  for (int cc = 0; cc < nch; ++cc) {
    const int nc = dir ? (nch - 1 - cc) : cc;
    LDS_BARRIER();
    UFOR(n, 8) {
      uint2 pk; pk.x = pk2(RT[n][0], RT[n][1]); pk.y = pk2(RT[n][2], RT[n][3]);
      *(uint2*)(smem + R_RT + (w * 16 + fr) * 272 + (n * 16 + fq * 4) * 2) = pk;
    }
    ret_stage(R, tid_, 0, rope, pw[63 - (tid_ >> 3)], 0.f);
    if (cc + 1 < nch) { const int nn = dir ? (nch - 2 - cc) : (cc + 1); ret_issue(p, R, tid_, 0, n0 + nn * 64, dir, h, rope, tseg0 + nn * 64); }
    f32x4 yprev[4];
    if (!dir) {
      UFOR(n, 4) yprev[n] = *(const f32x4*)(scr + (size_t)(nc * 64 + mt * 16 + fr) * 128 + (nh * 4 + n) * 16 + fq * 4);
    }
    LDS_BARRIER();
    f32x4 s[2] = {(f32x4){0.f, 0.f, 0.f, 0.f}, (f32x4){0.f, 0.f, 0.f, 0.f}};
    UFOR(ks, 4) {
      const bf16x8 a = ldsfrag(R_QS, mt * 16 + fr, 272, ks * 32 + fq * 8);
      UFOR(n, 2) s[n] = MFMA16(a, ldsfrag(R_KS, (nh * 2 + n) * 16 + fr, 272, ks * 32 + fq * 8), s[n]);
    }
    UFOR(n, 2) UFOR(j, 4) {
      const int i = mt * 16 + fq * 4 + j, m = (nh * 2 + n) * 16 + fr;
      const int df = i - m;
      float v = 0.f;
      if (dir ? (df > 0) : (df >= 0)) v = s[n][j] * pw[df];
      *(u16*)(smem + R_SS + i * 144 + m * 2) = f2bf(v);
    }
    f32x4 y[4];
    UFOR(n, 4) y[n] = (f32x4){0.f, 0.f, 0.f, 0.f};
    UFOR(ks, 4) {
      const bf16x8 a = ldsfrag(R_QS, mt * 16 + fr, 272, ks * 32 + fq * 8);
      UFOR(n, 4) y[n] = MFMA16(ldsfrag(R_RT, (nh * 4 + n) * 16 + fr, 272, ks * 32 + fq * 8), a, y[n]);
    }
    {
      const float xi = pw[mt * 16 + fr + 1];
      UFOR(n, 4) y[n] = y[n] * xi;
    }
    LDS_BARRIER();
    UFOR(ks, 2) {
      const bf16x8 a = ldsfrag(R_SS, mt * 16 + fr, 144, ks * 32 + fq * 8);
      UFOR(n, 4) y[n] = MFMA16(LDSFRAG_SWN(R_VT, n, ks, pl0, pl1, nh * 9216), a, y[n]);
    }
    UFOR(n, 8) UFOR(j, 4) RT[n][j] *= g64;
    UFOR(ks, 2) {
      const bf16x8 a = ldsfrag_sw(R_VT, w * 16 + fr, ks, fq);
      UFOR(n, 8) RT[n] = MFMA16(LDSFRAG_SWN(R_KT, n, ks, pl0, pl1, 0), a, RT[n]);
    }
    {
      const int i = mt * 16 + fr;
      const int tl = nc * 64 + (dir ? (63 - i) : i);
      UFOR(n, 4) {
        f32x4* d = (f32x4*)(scr + (size_t)tl * 128 + (nh * 4 + n) * 16 + fq * 4);
        if (dir) *d = y[n]; else *d = y[n] + yprev[n];
      }
    }
  }
}

__device__ __forceinline__ void phase_ret_out(KP p, int l, int with_ctx) {
  const int tid_ = tidx(); const int bid_ = bidx(); (void)bid_;
  p = kp_launder(p);
  const float* KV = (const float*)(p->ws + OFF_KV);
  float* scr = (float*)(p->ws + OFF_SCR) + (size_t)bid_ * 106496;
  u16* mix = (u16*)(p->ws + OFF_A);
  const u16* zcr = (const u16*)(p->ws + OFF_ZCR);
  const float* rng = p->in[21] + (size_t)l * RW;
  const int lane = tid_ & 63, w = tid_ >> 6;
  const int nitems = 12 * (with_ctx ? NSEG + 1 : NSEG);
  int it_step = gridDim.x;
  if ((int)gridDim.x > 12 * NSEG) it_step = (bid_ >= 12 * NSEG) ? ((int)gridDim.x - 12 * NSEG) : 12 * (NSEG + 1);
  for (int it = bid_; it < nitems; it += it_step) {
    int bh, seg;
    if (it < 12 * NSEG) { bh = it / NSEG; seg = it % NSEG; } else { bh = it - 12 * NSEG; seg = NSEG; }
    const int b = bh / 6, h = bh % 6;
    const int isctx = seg == NSEG;
    const int c0 = seg_c0(seg), tseg0 = c0 * 64;
    const int nch = isctx ? 4 : (seg_c0(seg + 1) - c0);
    const int n0 = isctx ? (ML + b * CTX) : (b * TL + tseg0);
    const float lgf = lg_gamma(h, 0), lgb = lg_gamma(h, 1);
    __syncthreads();
    if (tid_ < 130) { const int d = tid_ / 65, e = tid_ % 65; ((float*)(smem + R_TAB))[tid_] = expf((d ? lgb : lgf) * (float)e); }
    __syncthreads();
    f32x4 RT[8];
    UFOR(n, 8) RT[n] = (f32x4){0.f, 0.f, 0.f, 0.f};
    if (!isctx) {
      const float g12 = expf(lgb * 768.f), g13 = expf(lgb * 832.f);
      const f32x4* base = (const f32x4*)(KV + ((size_t)(bh * 2 + 1) * (NSEG + 1) * 512 + tid_) * 32);
      UFOR(n, 8) RT[n] = base[(size_t)NSEG * 4096 + n];
#pragma unroll 2
      for (int s = NSEG - 1; s > seg; --s) {
        f32x4 t[8];
        UFOR(n, 8) t[n] = base[(size_t)s * 4096 + n];
        const float gL = (seg_c0(s + 1) - seg_c0(s)) == 13 ? g13 : g12;
        UFOR(n, 8) RT[n] = RT[n] * gL + t[n];
      }
    }
    ret_pass(p, tid_, 1, n0, nch, h, !isctx, tseg0, RT, scr);
    __syncthreads();
    UFOR(n, 8) RT[n] = (f32x4){0.f, 0.f, 0.f, 0.f};
    if (!isctx) {
      const float g12 = expf(lgf * 768.f), g13 = expf(lgf * 832.f);
      const f32x4* base = (const f32x4*)(KV + ((size_t)(bh * 2 + 0) * (NSEG + 1) * 512 + tid_) * 32);
      UFOR(n, 8) RT[n] = base[(size_t)NSEG * 4096 + n];
#pragma unroll 2
      for (int s = 0; s < seg; ++s) {
        f32x4 t[8];
        UFOR(n, 8) t[n] = base[(size_t)s * 4096 + n];
        const float gL = (seg_c0(s + 1) - seg_c0(s)) == 13 ? g13 : g12;
        UFOR(n, 8) RT[n] = RT[n] * gL + t[n];
      }
    }
    ret_pass(p, tid_, 0, n0, nch, h, !isctx, tseg0, RT, scr);
    __syncthreads();
    {
      const int ntw = nch * 8;
      const float rg0 = rng[h * 128 + lane], rg1 = rng[h * 128 + 64 + lane];
      for (int k0 = 0; k0 < ntw; k0 += 8) {
        float v0[8], v1[8]; u16 g0[8], g1[8];
        UFOR(u, 8) {
          const int tl = w * ntw + k0 + u;
          const size_t row = (size_t)(n0 + tl);
          v0[u] = scr[(size_t)tl * 128 + lane]; v1[u] = scr[(size_t)tl * 128 + 64 + lane];
          g0[u] = zcr[row * CRC + 1536 + 2304 + h * 128 + lane]; g1[u] = zcr[row * CRC + 1536 + 2304 + h * 128 + 64 + lane];
        }
        UFOR(u, 8) {
          const int tl = w * ntw + k0 + u;
          const size_t row = (size_t)(n0 + tl);
          const float mu = wave_sum(v0[u] + v1[u]) * (1.f / 128.f);
          const float d0 = v0[u] - mu, d1 = v1[u] - mu;
          const float var = wave_sum(d0 * d0 + d1 * d1) * (1.f / 128.f);
          const float rstd = rsqrtf(var + 1e-6f);
          mix[row * DM + 1280 + h * 128 + lane] = f2bf(siluf_(bf2f(g0[u])) * d0 * rstd * rg0);
          mix[row * DM + 1280 + h * 128 + 64 + lane] = f2bf(siluf_(bf2f(g1[u])) * d1 * rstd * rg1);
        }
      }
    }
    __syncthreads();
  }
}

__device__ __forceinline__ void phase_convmix(KP p, int l, int nrows) {
  const int tid_ = tidx(); const int bid_ = bidx(); (void)bid_;
  p = kp_launder(p);
  const u16* zcr = (const u16*)(p->ws + OFF_ZCR);
  u16* mix = (u16*)(p->ws + OFF_A);
  const float* cw = p->in[20] + (size_t)l * 512 * 3;
  const int total = nrows * 64;
  for (int i = bid_ * NTHREADS + tid_; i < total; i += gridDim.x * NTHREADS) {
    const int r = i >> 6, c = (i & 63) * 8;
    int s0, len, mr; seqinfo(r, s0, len, mr);
    const u16* z = zcr + (size_t)r * CRC;
    float gb[8], cc[8], hh[8], pm[8], pp[8], t1[8], t2[8];
    unpack8(*(const uint4*)(z + c), gb);
    unpack8(*(const uint4*)(z + 512 + c), cc); unpack8(*(const uint4*)(z + 1024 + c), hh);
    UFOR(x, 8) { cc[x] *= hh[x]; pm[x] = 0.f; pp[x] = 0.f; }
    if (r - 1 >= s0) { unpack8(*(const uint4*)(z - CRC + 512 + c), t1); unpack8(*(const uint4*)(z - CRC + 1024 + c), t2); UFOR(x, 8) pm[x] = t1[x] * t2[x]; }
    if (r + 1 < s0 + len) { unpack8(*(const uint4*)(z + CRC + 512 + c), t1); unpack8(*(const uint4*)(z + CRC + 1024 + c), t2); UFOR(x, 8) pp[x] = t1[x] * t2[x]; }
    float o[8];
    UFOR(x, 8) o[x] = gb[x] * (pm[x] * cw[(c + x) * 3] + cc[x] * cw[(c + x) * 3 + 1] + pp[x] * cw[(c + x) * 3 + 2]);
    *(uint4*)(mix + (size_t)r * DM + 768 + c) = pack8(o);
  }
}

#define FA(i) ((u16*)(p->ws + OFF_FEAT + (size_t)(i) * FEAT_SZ))
#define F_AIN 0
#define F_KL 8448
#define F_KK 33024
#define F_RL 57600
#define F_SB 82176
#define F_STG 82944
__device__ __forceinline__ uint4 packh8(const float* f) {
  uint4 u;
  u.x = (unsigned)f2h(f[0]) | ((unsigned)f2h(f[1]) << 16); u.y = (unsigned)f2h(f[2]) | ((unsigned)f2h(f[3]) << 16);
  u.z = (unsigned)f2h(f[4]) | ((unsigned)f2h(f[5]) << 16); u.w = (unsigned)f2h(f[6]) | ((unsigned)f2h(f[7]) << 16);
  return u;
}
__device__ __forceinline__ void ld8f(const float* p_, float* f) {
  const float4 a = *(const float4*)p_, b = *(const float4*)(p_ + 4);
  f[0] = a.x; f[1] = a.y; f[2] = a.z; f[3] = a.w; f[4] = b.x; f[5] = b.y; f[6] = b.z; f[7] = b.w;
}
__device__ __forceinline__ void phase_features(KP p, int l) {
  const int tid_ = tidx(); const int bid_ = bidx(); (void)bid_;
  p = kp_launder(p);
  const u16* zrw = (const u16*)(p->ws + OFF_ZRW);
  const float* mu = p->in[9] + (size_t)l * RWC;
  const u16* lora = (const u16*)(p->ws + OFF_LORA) + (size_t)l * LORA_L;
  const u16* wupT = lora; const u16* aupT = lora + 98304; const u16* gupT = lora + 196608;
  const float* w0 = p->in[10] + (size_t)l * 2 * RW; const float* a0 = p->in[12] + (size_t)l * 2 * RW;
  const float* kk_ = p->in[15] + (size_t)l * RW; const float* ka_ = p->in[16] + (size_t)l * RW; const float* rk_ = p->in[17] + (size_t)l * RW;
  float* sb = (float*)(p->ws + OFF_SB);
  float* sbl = (float*)(smem + F_SB);
  const int lane = tid_ & 63, w = tid_ >> 6, fr = lane & 15, fq = lane >> 4;
  for (int it = bid_; it < MT / 16; it += gridDim.x) {
    const int R0 = it * 16;
    int s0, len, mr; seqinfo(R0, s0, len, mr);
    LDS_BARRIER();
    if (tid_ < 192) sbl[tid_] = 0.f;
#pragma unroll 9
    for (int i = 0; i < 9; ++i) {
      const int q = tid_ + 512 * i, tok = q / 288, grp = q % 288, sec = grp / 96, r = R0 + tok, col = grp * 8, ch = col - sec * RW;
      const bool hm = r - 1 >= s0, hp = r + 1 < s0 + len;
      const u16* z = zrw + (size_t)r * RWC + col;
      float c[8], a[8], b[8], o[8], m[8];
      unpack8(*(const uint4*)z, c);
      if (hm) unpack8(*(const uint4*)(z - RWC), a); else UFOR(x, 8) a[x] = 0.f;
      if (hp) unpack8(*(const uint4*)(z + RWC), b); else UFOR(x, 8) b[x] = 0.f;
      ld8f(mu + col, m);
      UFOR(x, 8) o[x] = c[x] + (0.5f * (a[x] + b[x]) - c[x]) * m[x];
      const uint4 pk = pack8(o);
      const size_t go = (size_t)r * RW + ch;
      if (sec == 0) { *(uint4*)(FA(0) + go) = pk; *(uint4*)(smem + F_RL + (tok * RW + ch) * 2) = pk; }
      else if (sec == 2) { *(uint4*)(FA(2) + go) = pk; }
      else {
        *(uint4*)(smem + F_KL + (tok * RW + ch) * 2) = pk;
        float kc[8], kq[8]; ld8f(kk_ + ch, kc);
        float ss = 0.f;
        UFOR(x, 8) { kq[x] = o[x] * kc[x]; ss += kq[x] * kq[x]; }
        ss += dppf<0xB1>(ss); ss += dppf<0x4E>(ss); ss += dppf<0x141>(ss);
        const float inv = 1.f / fmaxf(sqrtf(ss), 1e-12f);
        UFOR(x, 8) kq[x] *= inv;
        const uint4 pq = pack8(kq);
        *(uint4*)(FA(1) + go) = pq; *(uint4*)(smem + F_KK + (tok * RW + ch) * 2) = pq;
      }
    }
    {
      const int tok = tid_ >> 5, cg = tid_ & 31, r = R0 + tok;
      const bool hm = r - 1 >= s0, hp = r + 1 < s0 + len;
      const u16* z = zrw + (size_t)r * RWC + 2304 + cg * 8;
      float c[8], a[8], b[8], o[8], m[8];
      unpack8(*(const uint4*)z, c);
      if (hm) unpack8(*(const uint4*)(z - RWC), a); else UFOR(x, 8) a[x] = 0.f;
      if (hp) unpack8(*(const uint4*)(z + RWC), b); else UFOR(x, 8) b[x] = 0.f;
      ld8f(mu + 2304 + cg * 8, m);
      UFOR(x, 8) {
        const float v = c[x] + (0.5f * (a[x] + b[x]) - c[x]) * m[x];
        o[x] = (cg < 8) ? (1.f - 2.f / (1.f + __expf(2.f * v))) : ((cg < 16) ? v : sigmoidf_(v));
      }
      *(uint4*)(smem + F_AIN + tok * 528 + cg * 16) = pack8(o);
    }
    LDS_BARRIER();
    char* stg = smem + F_STG + w * 7168;
    for (int u = w * 3; u < w * 3 + 3; ++u) {
      const int hd = u >> 1, chb = hd * 64 + (u & 1) * 32;
      f32x4 aw0[2], aw1[2], aa0[2], aa1[2], ag[2];
      UFOR(n, 2) { aw0[n] = (f32x4){0.f, 0.f, 0.f, 0.f}; aw1[n] = aw0[n]; aa0[n] = aw0[n]; aa1[n] = aw0[n]; ag[n] = aw0[n]; }
      UFOR(ks, 2) {
        const bf16x8 atw = *(const bf16x8*)(smem + F_AIN + fr * 528 + (ks * 32 + fq * 8) * 2);
        const bf16x8 aad = *(const bf16x8*)(smem + F_AIN + fr * 528 + (64 + ks * 32 + fq * 8) * 2);
        UFOR(n, 2) {
          const int ch = chb + n * 16 + fr;
          aw0[n] = MFMA16(atw, *(const bf16x8*)(wupT + (size_t)ch * 64 + ks * 32 + fq * 8), aw0[n]);
          aw1[n] = MFMA16(atw, *(const bf16x8*)(wupT + (size_t)(RW + ch) * 64 + ks * 32 + fq * 8), aw1[n]);
          aa0[n] = MFMA16(aad, *(const bf16x8*)(aupT + (size_t)ch * 64 + ks * 32 + fq * 8), aa0[n]);
          aa1[n] = MFMA16(aad, *(const bf16x8*)(aupT + (size_t)(RW + ch) * 64 + ks * 32 + fq * 8), aa1[n]);
        }
      }
      UFOR(ks, 4) {
        const bf16x8 asg = *(const bf16x8*)(smem + F_AIN + fr * 528 + (128 + ks * 32 + fq * 8) * 2);
        UFOR(n, 2) {
          const int ch = chb + n * 16 + fr;
          ag[n] = MFMA16(asg, *(const bf16x8*)(gupT + (size_t)ch * 128 + ks * 32 + fq * 8), ag[n]);
        }
      }
      UFOR(n, 2) UFOR(j, 4) {
        const int e = (fq * 4 + j) * 32 + n * 16 + fr;
        ((float*)stg)[e] = aw0[n][j]; ((float*)(stg + 2048))[e] = aw1[n][j];
        ((u16*)(stg + 4096))[e] = f2bf(aa0[n][j]); ((u16*)(stg + 5120))[e] = f2bf(aa1[n][j]); ((u16*)(stg + 6144))[e] = f2bf(ag[n][j]);
      }
      asm volatile("s_waitcnt lgkmcnt(0)" ::: "memory");
      {
        const int tok = lane >> 2, g4 = lane & 3, ch = chb + g4 * 8, r = R0 + tok;
        float xw0[8], xw1[8], ya0[8], ya1[8], gg[8], kv[8], kkn[8], rr[8], cw0[8], cw1[8], ca0[8], ca1[8], cka[8], crk[8];
        ld8f((const float*)stg + tok * 32 + g4 * 8, xw0); ld8f((const float*)(stg + 2048) + tok * 32 + g4 * 8, xw1);
        unpack8(*(const uint4*)(stg + 4096 + (tok * 32 + g4 * 8) * 2), ya0); unpack8(*(const uint4*)(stg + 5120 + (tok * 32 + g4 * 8) * 2), ya1);
        unpack8(*(const uint4*)(stg + 6144 + (tok * 32 + g4 * 8) * 2), gg);
        unpack8(*(const uint4*)(smem + F_KL + (tok * RW + ch) * 2), kv); unpack8(*(const uint4*)(smem + F_KK + (tok * RW + ch) * 2), kkn);
        unpack8(*(const uint4*)(smem + F_RL + (tok * RW + ch) * 2), rr);
        ld8f(w0 + ch, cw0); ld8f(w0 + RW + ch, cw1); ld8f(a0 + ch, ca0); ld8f(a0 + RW + ch, ca1); ld8f(ka_ + ch, cka); ld8f(rk_ + ch, crk);
        float d0[8], d1[8], k0[8], k1[8], b0[8], b1[8];
        float bon = 0.f;
        UFOR(x, 8) {
          d0[x] = 0.6065306597126334f * sigmoidf_(cw0[x] + xw0[x]);
          d1[x] = 0.6065306597126334f * sigmoidf_(cw1[x] + xw1[x]);
          const float av0 = sigmoidf_(ca0[x] + ya0[x]), av1 = sigmoidf_(ca1[x] + ya1[x]);
          k0[x] = kv[x] * (1.f + (av0 - 1.f) * cka[x]); k1[x] = kv[x] * (1.f + (av1 - 1.f) * cka[x]);
          b0[x] = kkn[x] * av0; b1[x] = kkn[x] * av1;
          bon += rr[x] * 0.5f * (k0[x] + k1[x]) * crk[x];
        }
        const size_t go = (size_t)r * RW + ch;
        *(uint4*)(FA(3) + go) = packh8(d0); *(uint4*)(FA(4) + go) = packh8(d1);
        *(uint4*)(FA(5) + go) = pack8(k0); *(uint4*)(FA(6) + go) = pack8(k1);
        *(uint4*)(FA(7) + go) = pack8(b0); *(uint4*)(FA(8) + go) = pack8(b1);
        *(uint4*)(FA(9) + go) = pack8(gg);
        bon += dppf<0xB1>(bon); bon += dppf<0x4E>(bon);
        if (g4 == 0) atomicAdd(&sbl[tok * 12 + hd], bon);
      }
      asm volatile("s_waitcnt lgkmcnt(0)" ::: "memory");
    }
    LDS_BARRIER();
    if (tid_ < 192) sb[(size_t)(R0 + tid_ / 12) * 12 + (tid_ % 12)] = sbl[tid_];
  }
}

#define S_FEAT 0
#define S_V 81920
#define S_Y 86016
__device__ __forceinline__ int scan_row(int c, int s, int b, int dir) {
  if (c < 8) { const int ps = c * 32 + s; return ML + b * CTX + (dir ? (CTX - 1 - ps) : ps); }
  const int ps = (c - 8) * 32 + s; return b * TL + (dir ? (TL - 1 - ps) : ps);
}
__device__ __forceinline__ void phase_scan(KP p) {
  const int tid_ = tidx(); const int bid_ = bidx(); (void)bid_;
  p = kp_launder(p);
  const int tid = tid_, lane = tid & 63, w = tid >> 6;
  u16* Y = (u16*)(p->ws + OFF_Y);
  float* feat = (float*)(smem + S_FEAT);
  float* vbuf = (float*)(smem + S_V);
  float* ybuf = (float*)(smem + S_Y);
  const int NCH = 8 + TL / 32;
  for (int it = bid_; it < 192; it += gridDim.x) {
    const int rg = it & 3, dir = (it >> 2) & 1, bh = it >> 3, b = bh / 12, h = bh % 12;
    const u16* fr_ = FA(0); const u16* fkk = FA(1); const u16* fv = FA(2);
    const u16* fdw = FA(3 + dir); const u16* fkey = FA(5 + dir); const u16* fb = FA(7 + dir);
    u16* Yd = Y + (size_t)dir * MT * RW;
    f2 S01 = {0.f, 0.f}, S23 = {0.f, 0.f};
    const int rl = lane >> 4, cs = lane & 15;
    const int rowl = (w & 3) * 4 + rl;
    __syncthreads();
    const int pth = tid_ - 256, ppair = (pth >> 7) & 1, pt = pth & 127;
    uint4 rq[2][6];
    UFOR(x, 6) { rq[0][x] = make_uint4(0, 0, 0, 0); rq[1][x] = rq[0][x]; }
    if (w >= 4) {
      UFOR(e, 2) {
        const int q = pt + 128 * e, st = q >> 3, g8 = q & 7;
        const size_t o = (size_t)scan_row(ppair, st, b, dir) * RW + h * 64 + g8 * 8;
        rq[e][0] = *(const uint4*)(fr_ + o); rq[e][1] = *(const uint4*)(fdw + o); rq[e][2] = *(const uint4*)(fkey + o);
        rq[e][3] = *(const uint4*)(fkk + o); rq[e][4] = *(const uint4*)(fb + o); rq[e][5] = *(const uint4*)(fv + o);
      }
    }
    for (int c = -1; c < NCH; ++c) {
      if (w >= 4) {
        if (((c + 1) & 1) == ppair) {
          if (c + 1 < NCH) {
            const int buf = (c + 1) & 1;
            UFOR(e, 2) {
              const int q = pt + 128 * e, st = q >> 3, g8 = q & 7;
              float f[8];
              float* fd = feat + ((buf * 32 + st) * 5) * 64 + g8 * 8;
              unpack8(rq[e][0], f); *(float4*)(fd) = make_float4(f[0], f[1], f[2], f[3]); *(float4*)(fd + 4) = make_float4(f[4], f[5], f[6], f[7]);
              { const uint4 u = rq[e][1];
                f[0] = h2f((u16)(u.x & 0xffff)); f[1] = h2f((u16)(u.x >> 16)); f[2] = h2f((u16)(u.y & 0xffff)); f[3] = h2f((u16)(u.y >> 16));
                f[4] = h2f((u16)(u.z & 0xffff)); f[5] = h2f((u16)(u.z >> 16)); f[6] = h2f((u16)(u.w & 0xffff)); f[7] = h2f((u16)(u.w >> 16));
                UFOR(x, 8) f[x] = __expf(-f[x]);
                *(float4*)(fd + 64) = make_float4(f[0], f[1], f[2], f[3]); *(float4*)(fd + 68) = make_float4(f[4], f[5], f[6], f[7]); }
              unpack8(rq[e][2], f); *(float4*)(fd + 128) = make_float4(f[0], f[1], f[2], f[3]); *(float4*)(fd + 132) = make_float4(f[4], f[5], f[6], f[7]);
              unpack8(rq[e][3], f); *(float4*)(fd + 192) = make_float4(-f[0], -f[1], -f[2], -f[3]); *(float4*)(fd + 196) = make_float4(-f[4], -f[5], -f[6], -f[7]);
              unpack8(rq[e][4], f); *(float4*)(fd + 256) = make_float4(f[0], f[1], f[2], f[3]); *(float4*)(fd + 260) = make_float4(f[4], f[5], f[6], f[7]);
              if ((g8 >> 1) == rg) {
                unpack8(rq[e][5], f);
                float* vd = vbuf + (buf * 16 + (g8 & 1) * 8) * 32 + st;
                UFOR(x, 8) vd[x * 32] = f[x];
              }
            }
          }
          if (c + 3 < NCH) {
            UFOR(e, 2) {
              const int q = pt + 128 * e, st = q >> 3, g8 = q & 7;
              const size_t o = (size_t)scan_row(c + 3, st, b, dir) * RW + h * 64 + g8 * 8;
              rq[e][0] = *(const uint4*)(fr_ + o); rq[e][1] = *(const uint4*)(fdw + o); rq[e][2] = *(const uint4*)(fkey + o);
              rq[e][3] = *(const uint4*)(fkk + o); rq[e][4] = *(const uint4*)(fb + o); rq[e][5] = *(const uint4*)(fv + o);
            }
          }
        } else if (c >= 1) {
          const int buf = (c - 1) & 1;
          UFOR(e, 4) {
            const int q = pt + 128 * e, st = q >> 4, rw = q & 15;
            Yd[(size_t)scan_row(c - 1, st, b, dir) * RW + h * 64 + rg * 16 + rw] = f2bf(ybuf[(buf * 32 + st) * 16 + rw]);
          }
        }
      } else if (c >= 0) {
        const int buf = c & 1;
        const float* fbase = feat + (buf * 32) * 320 + cs * 4;
        const float* vb4 = vbuf + (buf * 16 + rowl) * 32;
        const bool b3 = (cs & 8) != 0, b2 = (cs & 4) != 0;
        float* yb = ybuf + (buf * 32 + (b3 ? 2 : 0) + (b2 ? 1 : 0)) * 16 + rowl;
        float4 Ar, Aw, Ak, An, Ab, Br, Bw, Bk, Bn, Bb, Cr, Cw, Ck, Cn, Cb, Dr, Dw, Dk, Dn, Db;
        float4 vcur = *(const float4*)vb4, vnext;
        float q0 = 0.f, q1 = 0.f, q2 = 0.f, q3 = 0.f, p0 = 0.f, p1 = 0.f, p2 = 0.f, p3 = 0.f;
#define SLD(R, st_) { const float* fd = fbase + (st_) * 320; R##r = *(const float4*)fd; R##w = *(const float4*)(fd + 64); R##k = *(const float4*)(fd + 128); \
                      R##n = *(const float4*)(fd + 192); R##b = *(const float4*)(fd + 256); }
#define SCOMP(R, VV, QQ) { \
          f2 p = S01 * (f2){R##n.x, R##n.y}; p = S23 * (f2){R##n.z, R##n.w} + p; \
          float sa = red16(p.x + p.y); \
          f2 u01 = (f2){R##k.x, R##k.y} * (VV); u01 = S01 * (f2){R##w.x, R##w.y} + u01; \
          f2 u23 = (f2){R##k.z, R##k.w} * (VV); u23 = S23 * (f2){R##w.z, R##w.w} + u23; \
          S01 = (f2){R##b.x, R##b.y} * sa + u01; S23 = (f2){R##b.z, R##b.w} * sa + u23; \
          f2 q = S01 * (f2){R##r.x, R##r.y}; q = S23 * (f2){R##r.z, R##r.w} + q; \
          QQ = q.x + q.y; }
#define YRED4(dst) { \
          float a0 = b3 ? p2 : p0, a1 = b3 ? p3 : p1; const float s0 = b3 ? p0 : p2, s1 = b3 ? p1 : p3; \
          a0 += dppf<0x128>(s0); a1 += dppf<0x128>(s1); \
          float cc = b2 ? a1 : a0; const float dd = b2 ? a0 : a1; \
          cc += dppf<0x141>(dd); cc += dppf<0xB1>(cc); cc += dppf<0x4E>(cc); dst = cc; }
        SLD(A, 0); SLD(B, 1);
        for (int g = 0; g < 8; ++g) {
          const int st = g * 4;
          SLD(C, st + 2); vnext = *(const float4*)(vb4 + st + 4);
          __builtin_amdgcn_sched_barrier(0);
          if (g > 0) { float yv; YRED4(yv); yb[(st - 4) * 16] = yv; }
          SCOMP(A, vcur.x, q0);
          SLD(D, st + 3);
          __builtin_amdgcn_sched_barrier(0);
          SCOMP(B, vcur.y, q1);
          SLD(A, st + 4);
          __builtin_amdgcn_sched_barrier(0);
          SCOMP(C, vcur.z, q2);
          SLD(B, st + 5);
          __builtin_amdgcn_sched_barrier(0);
          SCOMP(D, vcur.w, q3);
          vcur = vnext; p0 = q0; p1 = q1; p2 = q2; p3 = q3;
        }
        { float yv; YRED4(yv); yb[28 * 16] = yv; }
#undef SLD
#undef SCOMP
#undef YRED4
      }
      asm volatile("s_waitcnt lgkmcnt(0)" ::: "memory");
      __builtin_amdgcn_s_barrier();
      asm volatile("" ::: "memory");
    }
    if (w >= 4) {
      const int buf = (NCH - 1) & 1;
      for (int q = pth; q < 512; q += 256) {
        const int st = q >> 4, rw = q & 15;
        Yd[(size_t)scan_row(NCH - 1, st, b, dir) * RW + h * 64 + rg * 16 + rw] = f2bf(ybuf[(buf * 32 + st) * 16 + rw]);
      }
    }
    __syncthreads();
  }
}

__device__ __forceinline__ void phase_rwkv_out(KP p, int l, int nrows) {
  const int tid_ = tidx(); const int bid_ = bidx(); (void)bid_;
  p = kp_launder(p);
  const u16* Y = (const u16*)(p->ws + OFF_Y);
  const float* sb = (const float*)(p->ws + OFF_SB);
  u16* mix = (u16*)(p->ws + OFF_A);
  const float* lg = p->in[18] + (size_t)l * RW; const float* lb = p->in[19] + (size_t)l * RW;
  const int lane = tid_ & 63, w = tid_ >> 6;
  for (int r = bid_ * 8 + w; r < nrows; r += gridDim.x * 8) {
    uint2 yf[3], yb[3], vv[3], gg[3]; float sbv[3];
    UFOR(j, 3) {
      const size_t o = (size_t)r * RW + j * 256 + lane * 4;
      yf[j] = *(const uint2*)(Y + o); yb[j] = *(const uint2*)(Y + (size_t)MT * RW + o);
      vv[j] = *(const uint2*)(FA(2) + o); gg[j] = *(const uint2*)(FA(9) + o);
      sbv[j] = sb[(size_t)r * 12 + j * 4 + (lane >> 4)];
    }
    UFOR(j, 3) {
      const int c = j * 256 + lane * 4;
      float y[4] = {lo2f(yf[j].x) + lo2f(yb[j].x), hi2f(yf[j].x) + hi2f(yb[j].x), lo2f(yf[j].y) + lo2f(yb[j].y), hi2f(yf[j].y) + hi2f(yb[j].y)};
      const float mu = red16((y[0] + y[1]) + (y[2] + y[3])) * (1.f / 64.f);
      UFOR(x, 4) y[x] -= mu;
      const float var = red16((y[0] * y[0] + y[1] * y[1]) + (y[2] * y[2] + y[3] * y[3])) * (1.f / 64.f);
      const float rstd = rsqrtf(var + 64e-5f);
      const float4 lgv = *(const float4*)(lg + c), lbv = *(const float4*)(lb + c);
      const float v[4] = {lo2f(vv[j].x), hi2f(vv[j].x), lo2f(vv[j].y), hi2f(vv[j].y)};
      const float g[4] = {lo2f(gg[j].x), hi2f(gg[j].x), lo2f(gg[j].y), hi2f(gg[j].y)};
      const float o0 = (y[0] * rstd * lgv.x + lbv.x + sbv[j] * v[0]) * g[0];
      const float o1 = (y[1] * rstd * lgv.y + lbv.y + sbv[j] * v[1]) * g[1];
      const float o2 = (y[2] * rstd * lgv.z + lbv.z + sbv[j] * v[2]) * g[2];
      const float o3 = (y[3] * rstd * lgv.w + lbv.w + sbv[j] * v[3]) * g[3];
      uint2 pk; pk.x = pk2(o0, o1); pk.y = pk2(o2, o3);
      *(uint2*)(mix + (size_t)r * DM + c) = pk;
    }
  }
}


#define XB_TMO      128
#define XB_XCNT(j)  (256  + 64 * (j))
#define XB_XSUB(j)  (1280 + 64 * (j))
#define XB_XGEN(j)  (2304 + 64 * (j))
#define XB_TOP      3328
#define XB_TOPGEN   3392
#define XCD_BAR_WORDS 3456
#define XB_SPIN_CAP (1u << 18)
#define LAS __attribute__((address_space(3)))
__device__ __forceinline__ unsigned xb_ld(unsigned* p)              { return __hip_atomic_load(p, __ATOMIC_RELAXED, __HIP_MEMORY_SCOPE_AGENT); }
__device__ __forceinline__ unsigned xb_add(unsigned* p, unsigned v) { return __hip_atomic_fetch_add(p, v, __ATOMIC_RELAXED, __HIP_MEMORY_SCOPE_AGENT); }
__device__ __forceinline__ unsigned xb_xcc_id() { return (unsigned)__builtin_amdgcn_s_getreg((3 << 11) | 20) & 0xFu; }
#define XB_SPIN(cond, bar) do { unsigned _sp = 0; while (cond) { __builtin_amdgcn_s_sleep(1); \
    if ((++_sp & 255u) == 0u) { if (xb_ld(&(bar)[XB_TMO])) break; if (_sp > XB_SPIN_CAP) { atomicAdd(&(bar)[XB_TMO], 1u); break; } } } } while (0)
struct XcdBarrier { unsigned* bar; unsigned x; volatile LAS unsigned* st; };
__device__ __forceinline__ XcdBarrier xcd_barrier_post(unsigned* bar, volatile LAS unsigned* st) {
    XcdBarrier b; b.bar = bar; b.x = xb_xcc_id(); b.st = st;
    if (threadIdx.x == 0) (void)xb_add(&bar[XB_XCNT(b.x)], 1u);
    return b;
}
__device__ __forceinline__ void xcd_barrier_complete(unsigned* bar, unsigned x, unsigned& nloc, unsigned& nx) {
    const unsigned G = gridDim.x * gridDim.y * gridDim.z;
    unsigned sum, cnt, mine, sp = 0u;
    for (;;) {
        sum = 0u; cnt = 0u; mine = 0u;
#pragma unroll
        for (unsigned j = 0; j < 16; ++j) { const unsigned c = xb_ld(&bar[XB_XCNT(j)]); sum += c; cnt += (c > 0u) ? 1u : 0u; mine = (j == x) ? c : mine; }
        if (sum == G) break;
        __builtin_amdgcn_s_sleep(1);
        if ((++sp & 255u) == 0u) { if (xb_ld(&bar[XB_TMO])) break; if (sp > XB_SPIN_CAP) { atomicAdd(&bar[XB_TMO], 1u); break; } }
    }
    nloc = mine > 0u ? mine : 1u; nx = cnt > 0u ? cnt : 1u;
}
__device__ __forceinline__ void xcd_barrier(const XcdBarrier& b) {
    asm volatile("s_waitcnt vmcnt(0)" ::: "memory");
    __syncthreads();
    if (threadIdx.x == 0) {
        unsigned* bar = b.bar;
        __builtin_amdgcn_s_waitcnt(0);
        unsigned nloc = b.st[0], nx = b.st[1];
        if (nloc == 0u) { xcd_barrier_complete(bar, b.x, nloc, nx); b.st[0] = nloc; b.st[1] = nx; }
        const unsigned old = xb_add(&bar[XB_XSUB(b.x)], 1u);
        const unsigned gen = old / nloc;
        if (old + 1u == (gen + 1u) * nloc) {
            __builtin_amdgcn_fence(__ATOMIC_RELEASE, "agent");
            asm volatile("s_waitcnt vmcnt(0)" ::: "memory");
            const unsigned og = xb_add(&bar[XB_TOP], 1u);
            const unsigned tg = og / nx;
            if (og + 1u == (tg + 1u) * nx) xb_add(&bar[XB_TOPGEN], 1u);
            else XB_SPIN(xb_ld(&bar[XB_TOPGEN]) == tg, bar);
            __builtin_amdgcn_fence(__ATOMIC_ACQUIRE, "agent");
            xb_add(&bar[XB_XGEN(b.x)], 1u);
            asm volatile("s_waitcnt vmcnt(0)" ::: "memory");
        } else {
            XB_SPIN(xb_ld(&bar[XB_XGEN(b.x)]) == gen, bar);
            __builtin_amdgcn_fence(__ATOMIC_ACQUIRE, "agent");
            asm volatile("s_waitcnt vmcnt(0)" ::: "memory");
        }
    }
    __syncthreads();
}

#ifndef REP_SCAN
#define REP_SCAN 1
#endif
#ifndef REP_FEAT
#define REP_FEAT 1
#endif
#ifndef REP_R3
#define REP_R3 1
#endif
#ifndef REP_ROUT
#define REP_ROUT 1
#endif
#ifndef REP_GIN
#define REP_GIN 1
#endif
__global__ void __launch_bounds__(NTHREADS) fwd_kernel(Params pk_unused, int ph_lo, int ph_hi, int use_sync) {
  KP p = (KP)__builtin_amdgcn_kernarg_segment_ptr();
  cg::grid_group grid = cg::this_grid();
  volatile LAS unsigned* xst = (volatile LAS unsigned*)(smem + LDS_BYTES - 16);
  if (threadIdx.x == 0) { xst[0] = 0u; xst[1] = 0u; xst[2] = 0u; xst[3] = 0u; }
  __syncthreads();
  XcdBarrier xb = xcd_barrier_post((unsigned*)(p->ws + OFF_BAR), xst);
  int ph = 0;
#define PHASE_BEGIN if (ph >= ph_lo && ph < ph_hi) {
#define PHASE_END } if (use_sync && ph >= ph_lo && ph + 1 < ph_hi) { if (ph == 0) grid.sync(); else xcd_barrier(xb); } ++ph;
  const float* mods = (const float*)(p->ws + OFF_MODS);
  PHASE_BEGIN
    phase_mods(p);
    __syncthreads();
    convert_win(p, 0, 0, gridDim.x);
    convert_wout(p, 0, 0, gridDim.x);
    phase_misc0(p);
  PHASE_END
  for (int l = 0; l < 2; ++l) {
    const float* modl = mods + (size_t)l * 3 * 12288;
    PHASE_BEGIN
      phase_norm(p, l, 0, MT);
    PHASE_END
    PHASE_BEGIN
      EpiArgs e{}; e.zrw = (u16*)(p->ws + OFF_ZRW); e.zcr = (u16*)(p->ws + OFF_ZCR);
      for (int rep = 0; rep < REP_GIN; ++rep) gemm_phase<EPI_Z, DM>((const u16*)(p->ws + OFF_A), (const u16*)(p->ws + OFF_WIN), MT / 256, INC / 256, e);
    PHASE_END
    PHASE_BEGIN
      phase_ret_summaries(p);
      __syncthreads();
      phase_convmix(p, l, l == 1 ? ML : MT);
    PHASE_END
    PHASE_BEGIN
      for (int rep = 0; rep < REP_R3; ++rep) phase_ret_out(p, l, l == 0);
    PHASE_END
    PHASE_BEGIN
      for (int rep = 0; rep < REP_FEAT; ++rep) phase_features(p, l);
    PHASE_END
    PHASE_BEGIN
      phase_scan(p);
      {
        const int cf = gridDim.x > 192 ? 192 : 0, cs_ = gridDim.x > 192 ? (int)gridDim.x - 192 : (int)gridDim.x;
        __syncthreads();
        convert_ffn(p, l, cf, cs_);
        if (l == 0) convert_win(p, 1, cf, cs_);
      }
    PHASE_END
    PHASE_BEGIN
      for (int rep = 0; rep < REP_ROUT; ++rep) phase_rwkv_out(p, l, l == 1 ? ML : MT);
    PHASE_END
    PHASE_BEGIN
      EpiArgs e{};
      e.srcL = (l == 0) ? p->in[0] : p->out; e.srcC = (l == 0) ? p->in[2] : (const float*)(p->ws + OFF_XC);
      e.dstL = p->out; e.dstC = (float*)(p->ws + OFF_XC); e.gate = modl + 2 * DM;
      gemm_phase<EPI_RES, DM>((const u16*)(p->ws + OFF_A), (const u16*)(p->ws + OFF_WOUT), l == 1 ? 128 : 130, DM / 256, e);
    PHASE_END
    PHASE_BEGIN
      phase_norm(p, l, 1, l == 1 ? ML : MT);
      if (l == 0) { __syncthreads(); convert_wout(p, 1, 0, gridDim.x); }
    PHASE_END
    PHASE_BEGIN
      EpiArgs e{}; e.h2 = (u16*)(p->ws + OFF_H2); e.cw = p->in[24] + (size_t)l * 2 * DFF * 3;
      gemm_phase<EPI_UPG, DM>((const u16*)(p->ws + OFF_A), (const u16*)(p->ws + OFF_WUP), l == 1 ? 130 : 132, DFF / 128, e);
    PHASE_END
    PHASE_BEGIN
      EpiArgs e{};
      e.srcL = p->out; e.srcC = (const float*)(p->ws + OFF_XC); e.dstL = p->out; e.dstC = (float*)(p->ws + OFF_XC); e.gate = modl + 5 * DM;
      gemm_phase<EPI_RES, DFF>((const u16*)(p->ws + OFF_H2), (const u16*)(p->ws + OFF_WDN), 128, DM / 256, e);
      if (l == 0) gemm_ctx_splitk_down((const u16*)(p->ws + OFF_H2), (const u16*)(p->ws + OFF_WDN), (float*)(p->ws + OFF_P2), e);
    PHASE_END
  }
  PHASE_BEGIN
    phase_final(p);
  PHASE_END
}

#define NPHASES 24

extern "C" void kernel_launch(void* const* d_in, const int* in_sizes, int n_in, void* d_out, int out_size, void* d_ws, size_t ws_size,
                              hipStream_t stream) {
  static int grid = 0;
  if (grid == 0) {
    int dev = 0, cus = 0, per_cu = 0;
    hipGetDevice(&dev);
    hipDeviceGetAttribute(&cus, hipDeviceAttributeMultiprocessorCount, dev);
    hipFuncSetAttribute((const void*)fwd_kernel, hipFuncAttributeMaxDynamicSharedMemorySize, LDS_BYTES);
    hipOccupancyMaxActiveBlocksPerMultiprocessor(&per_cu, (const void*)fwd_kernel, NTHREADS, LDS_BYTES);
    (void)hipGetLastError();
    if (per_cu < 1) per_cu = 1;
    grid = cus;
    if (ws_size < 952 * MIB) fprintf(stderr, "kernel_launch: workspace too small: %zu\n", ws_size);
  }
  if (hipMemsetAsync((char*)d_ws + OFF_BAR, 0, 16384, stream) != hipSuccess) fprintf(stderr, "kernel_launch: memset of barrier words failed\n");
  Params p{};
  UFOR(i, 27) p.in[i] = (const float*)d_in[i];
  p.out = (float*)d_out;
  p.ws = (char*)d_ws;
  int lo = 0, hi = NPHASES, us = 1;
  void* args[] = {&p, &lo, &hi, &us};
  hipError_t e = hipLaunchCooperativeKernel((const void*)fwd_kernel, dim3(grid), dim3(NTHREADS), args, LDS_BYTES, stream);
  if (e != hipSuccess) fprintf(stderr, "cooperative launch failed: %s (grid %d)\n", hipGetErrorString(e), grid);
}
```

```cpp
#include <hip/hip_runtime.h>
#include <hip/hip_cooperative_groups.h>
#include <cstdio>
#include <cstdint>
namespace cg = cooperative_groups;

typedef unsigned short u16;
typedef short bf16x8 __attribute__((ext_vector_type(8)));
typedef float f32x4 __attribute__((ext_vector_type(4)));
typedef float f2 __attribute__((ext_vector_type(2)));
#define UFOR(v, n) _Pragma("unroll") for (int v = 0; v < (n); ++v)

#define DM 2048
#define TL 16384
#define CTX 256
#define ML 32768
#define MT 33280
#define RW 768
#define RWC 2560
#define CRC 4608
#define INC 7168
#define DFF 5632
#define NTHREADS 512
#define LDS_BYTES 147456

#define MIB ((size_t)1 << 20)
#define OFF_MODS ((size_t)0)
#define OFF_BAR ((size_t)524288)
#define OFF_ROPE (1 * MIB)
#define OFF_XC (9 * MIB)
#define OFF_SB (13 * MIB)
#define OFF_LORA (15 * MIB)
#define OFF_KV (17 * MIB)
#define OFF_WIN (67 * MIB)
#define OFF_WOUT (95 * MIB)
#define OFF_WUP (103 * MIB)
#define OFF_WDN (147 * MIB)
#define OFF_A (170 * MIB)
#define OFF_ZRW (301 * MIB)
#define OFF_ZCR (464 * MIB)
#define OFF_SCR (757 * MIB)
#define FEAT_SZ ((size_t)MT * RW * 2)
#define OFF_FEAT OFF_ZCR
#define OFF_Y OFF_ZRW
#define OFF_H2 OFF_ZCR
#define LORA_L 294912

struct Params {
  const float* in[27];
  float* out;
  char* ws;
};

typedef const __attribute__((address_space(4))) Params* KP;
__device__ __forceinline__ KP kp_launder(KP k) { unsigned z; asm volatile("s_mov_b32 %0, 0" : "=s"(z)); return (KP)((const __attribute__((address_space(4))) char*)__builtin_amdgcn_kernarg_segment_ptr() + z); }

extern __shared__ __attribute__((aligned(16))) char smem[];
#define LDS_BARRIER() do { asm volatile("s_waitcnt lgkmcnt(0)" ::: "memory"); __builtin_amdgcn_s_barrier(); asm volatile("" ::: "memory"); } while (0)

__device__ __forceinline__ u16 f2bf(float f) {
  unsigned u = __float_as_uint(f);
  u += 0x7fffu + ((u >> 16) & 1u);
  return (u16)(u >> 16);
}
__device__ __forceinline__ float bf2f(u16 h) { return __uint_as_float(((unsigned)h) << 16); }
__device__ __forceinline__ unsigned pk2(float a, float b) { return (unsigned)f2bf(a) | ((unsigned)f2bf(b) << 16); }
__device__ __forceinline__ float lo2f(unsigned u) { return __uint_as_float(u << 16); }
__device__ __forceinline__ float hi2f(unsigned u) { return __uint_as_float(u & 0xffff0000u); }
__device__ __forceinline__ u16 f2h(float f) { _Float16 h = (_Float16)f; return __builtin_bit_cast(u16, h); }
__device__ __forceinline__ float h2f(u16 u) { _Float16 h = __builtin_bit_cast(_Float16, u); return (float)h; }
template <int CTRL>
__device__ __forceinline__ float dppf(float v) {
  return __int_as_float(__builtin_amdgcn_mov_dpp(__float_as_int(v), CTRL, 0xf, 0xf, true));
}
__device__ __forceinline__ float red16(float v) {
  v += dppf<0xB1>(v);
  v += dppf<0x4E>(v);
  v += dppf<0x141>(v);
  v += dppf<0x140>(v);
  return v;
}
__device__ __forceinline__ float wave_sum(float v) {
  v = red16(v);
  const int iv = __float_as_int(v);
  return (__int_as_float(__builtin_amdgcn_readlane(iv, 0)) + __int_as_float(__builtin_amdgcn_readlane(iv, 16))) +
         (__int_as_float(__builtin_amdgcn_readlane(iv, 32)) + __int_as_float(__builtin_amdgcn_readlane(iv, 48)));
}
__device__ __forceinline__ int tidx() { int t = threadIdx.x; asm volatile("" : "+v"(t)); return t; }
__device__ __forceinline__ int bidx() { int t = blockIdx.x; asm volatile("" : "+s"(t)); return t; }
__device__ __forceinline__ float sigmoidf_(float x) { return 1.f / (1.f + __expf(-x)); }
__device__ __forceinline__ float siluf_(float x) { return x / (1.f + __expf(-x)); }
__device__ __forceinline__ void seqinfo(int r, int& s0, int& len, int& mrow) {
  if (r < ML) { int b = r >> 14; s0 = b << 14; len = TL; mrow = b; }
  else { int b = (r - ML) >> 8; s0 = ML + (b << 8); len = CTX; mrow = 2; }
}
__device__ __forceinline__ void unpack8(uint4 u, float* f) {
  f[0] = lo2f(u.x); f[1] = hi2f(u.x); f[2] = lo2f(u.y); f[3] = hi2f(u.y);
  f[4] = lo2f(u.z); f[5] = hi2f(u.z); f[6] = lo2f(u.w); f[7] = hi2f(u.w);
}
__device__ __forceinline__ uint4 pack8(const float* f) {
  uint4 u; u.x = pk2(f[0], f[1]); u.y = pk2(f[2], f[3]); u.z = pk2(f[4], f[5]); u.w = pk2(f[6], f[7]); return u;
}

__device__ __forceinline__ void transpose_convert(const float* __restrict__ W, int K, int N, u16* __restrict__ WT, int mode, int bfirst, int bstride) {
  const int tid_ = tidx(); const int bid_ = bidx(); (void)bid_;
  float* tile = (float*)smem;
  const int tk = K / 64, tn = N / 128, nit = tk * tn;
  const int lr = tid_ >> 5, lc = (tid_ & 31) * 4;
  float4 v[4];
  int it = bid_ - bfirst;
  if (it < 0) return;
  if (it < nit) {
    const int k0 = (it / tn) * 64, n0 = (it % tn) * 128;
    UFOR(i, 4) v[i] = *(const float4*)(W + (size_t)(k0 + lr + 16 * i) * N + n0 + lc);
  }
  while (it < nit) {
    const int k0 = (it / tn) * 64, n0 = (it % tn) * 128;
    UFOR(i, 4) { float* t = tile + (lr + 16 * i) * 129 + lc; t[0] = v[i].x; t[1] = v[i].y; t[2] = v[i].z; t[3] = v[i].w; }
    LDS_BARRIER();
    const int nx = it + bstride;
    if (nx < nit) {
      const int k1 = (nx / tn) * 64, n1 = (nx % tn) * 128;
      UFOR(i, 4) v[i] = *(const float4*)(W + (size_t)(k1 + lr + 16 * i) * N + n1 + lc);
    }
    const int n = tid_ >> 2, kc = tid_ & 3;
    float f[16];
    UFOR(i, 16) f[i] = tile[(kc * 16 + i) * 129 + n];
    const int ng = n0 + n;
    int dn = ng;
    if (mode == 1) dn = (ng < DFF) ? ((ng >> 7) * 256 + (ng & 127)) : ((((ng - DFF) >> 7) * 256) + 128 + ((ng - DFF) & 127));
    dn = (dn & ~31) | ((((dn >> 2) & 1) << 4) | (((dn >> 3) & 3) << 2) | (dn & 3));
    u16* d = WT + (size_t)dn * K + k0 + kc * 16;
    *(uint4*)d = pack8(f); *(uint4*)(d + 8) = pack8(f + 8);
    LDS_BARRIER();
    it = nx;
  }
}

__device__ __forceinline__ void phase_mods(KP p) {
  const int tid_ = tidx(); const int bid_ = bidx(); (void)bid_;
  p = kp_launder(p);
  float* sc = (float*)smem;
  float* red = sc + 3 * DM;
  float* mods = (float*)(p->ws + OFF_MODS);
  const int tid = tid_;
  for (int i = tid; i < 3 * DM; i += NTHREADS) {
    const float v = (i < 2 * DM) ? p->in[1][i] : p->in[3][i - 2 * DM];
    sc[i] = siluf_(v);
  }
  __syncthreads();
  for (int it = bid_; it < 256; it += gridDim.x) {
    const int l = it >> 7, col0 = (it & 127) * 96;
    const float* W = p->in[4] + (size_t)l * DM * 12288;
    const int kg = tid / 24, c4 = tid % 24;
    float acc[3][4] = {};
    if (kg < 21) {
#pragma unroll 8
      for (int k = kg; k < DM; k += 21) {
        const float4 w = *(const float4*)(W + (size_t)k * 12288 + col0 + c4 * 4);
        UFOR(m, 3) {
          const float s = sc[m * DM + k];
          acc[m][0] += s * w.x; acc[m][1] += s * w.y; acc[m][2] += s * w.z; acc[m][3] += s * w.w;
        }
      }
      UFOR(m, 3)
        UFOR(q, 4) red[(kg * 3 + m) * 96 + c4 * 4 + q] = acc[m][q];
    }
    __syncthreads();
    if (tid < 288) {
      const int m = tid / 96, c = tid % 96;
      float s = 0.f;
      UFOR(g, 21) s += red[(g * 3 + m) * 96 + c];
      mods[(size_t)(l * 3 + m) * 12288 + col0 + c] = s + p->in[5][(size_t)l * 12288 + col0 + c];
    }
    __syncthreads();
  }
}

__device__ __forceinline__ void phase_misc0(KP p) {
  const int tid_ = tidx(); const int bid_ = bidx(); (void)bid_;
  p = kp_launder(p);
  const int gtid = bid_ * NTHREADS + tid_, gn = gridDim.x * NTHREADS;
  float* rc = (float*)(p->ws + OFF_ROPE);
  float* rs = rc + TL * 64;
  for (int i = gtid; i < TL * 64; i += gn) {
    const int t = i >> 6, j = i & 63;
    const float fr = 1.0f / powf(10000.0f, (float)(j & 31) / 32.0f);
    const float pos = (j < 32) ? (float)(t >> 6) : (float)(t & 63);
    const float ang = pos * fr;
    rc[i] = cosf(ang); rs[i] = sinf(ang);
  }
  u16* lora = (u16*)(p->ws + OFF_LORA);
  for (int i = gtid; i < 2 * LORA_L; i += gn) {
    const int l = i / LORA_L; int r = i % LORA_L;
    float v;
    if (r < 98304) { const int d = r / 49152, q = r % 49152, ch = q >> 6, k = q & 63; v = p->in[11][((size_t)(l * 2 + d) * 64 + k) * RW + ch]; }
    else if (r < 196608) { r -= 98304; const int d = r / 49152, q = r % 49152, ch = q >> 6, k = q & 63; v = p->in[13][((size_t)(l * 2 + d) * 64 + k) * RW + ch]; }
    else { r -= 196608; const int ch = r >> 7, k = r & 127; v = p->in[14][((size_t)l * 128 + k) * RW + ch]; }
    lora[i] = f2bf(v);
  }
}

__device__ __forceinline__ void convert_win(KP p, int l, int bf, int bs) { transpose_convert(p->in[8] + (size_t)l * DM * INC, DM, INC, (u16*)(p->ws + OFF_WIN), 0, bf, bs); }
__device__ __forceinline__ void convert_wout(KP p, int l, int bf, int bs) { transpose_convert(p->in[22] + (size_t)l * DM * DM, DM, DM, (u16*)(p->ws + OFF_WOUT), 0, bf, bs); }
__device__ __forceinline__ void convert_ffn(KP p, int l, int bf, int bs) {
  transpose_convert(p->in[23] + (size_t)l * DM * 2 * DFF, DM, 2 * DFF, (u16*)(p->ws + OFF_WUP), 1, bf, bs);
  transpose_convert(p->in[25] + (size_t)l * DFF * DM, DFF, DM, (u16*)(p->ws + OFF_WDN), 0, bf, bs);
}

__device__ __forceinline__ const float* norm_src(KP p, int l, int which, int r) {
  if (r < ML) return ((l == 0 && which == 0) ? p->in[0] : p->out) + (size_t)r * DM;
  return ((l == 0 && which == 0) ? p->in[2] : (const float*)(p->ws + OFF_XC)) + (size_t)(r - ML) * DM;
}
__device__ __forceinline__ void phase_norm(KP p, int l, int which, int nrows) {
  const int tid_ = tidx(); const int bid_ = bidx(); (void)bid_;
  p = kp_launder(p);
  const float* mods = (const float*)(p->ws + OFF_MODS) + (size_t)l * 3 * 12288;
  const float* g = p->in[which ? 7 : 6] + (size_t)l * DM;
  u16* A = (u16*)(p->ws + OFF_A);
  const int lane = tid_ & 63, wv = tid_ >> 6;
  const int sh = which ? 3 : 0, scl = which ? 4 : 1;
  const int stride = gridDim.x * 8;
  float4 va[8], vb[8];
#define NORM_LOAD(V, R_) { const float* s = norm_src(p, l, which, (R_)); UFOR(j, 8) V[j] = *(const float4*)(s + j * 256 + lane * 4); \
    if (l == 1 && which == 0 && (R_) >= ML) {     \
      const float* gt5 = (const float*)(p->ws + OFF_MODS) + (size_t)2 * 12288 + 5 * DM; \
      const float* pp = (const float*)(p->ws + (832 * MIB)) + (size_t)((R_) - ML) * DM; \
      UFOR(j, 8) { \
        const int c = j * 256 + lane * 4; \
        float4 acc4 = make_float4(0.f, 0.f, 0.f, 0.f); \
        for (int pt_ = 0; pt_ < 11; ++pt_) { const float4 q = *(const float4*)(pp + (size_t)pt_ * 512 * DM + c); acc4.x += q.x; acc4.y += q.y; acc4.z += q.z; acc4.w += q.w; } \
        const float4 g5 = *(const float4*)(gt5 + c); \
        V[j].x += g5.x * acc4.x; V[j].y += g5.y * acc4.y; V[j].z += g5.z * acc4.z; V[j].w += g5.w * acc4.w; } } }
#define NORM_BODY(V, R_) { \
    const int rr = (R_); const int mrow = rr < ML ? (rr >> 14) : 2; \
    float ss = 0.f; \
    UFOR(j, 8) ss += V[j].x * V[j].x + V[j].y * V[j].y + V[j].z * V[j].z + V[j].w * V[j].w; \
    ss = wave_sum(ss); \
    const float rstd = rsqrtf(ss * (1.0f / DM) + 1e-6f); \
    const float* ms = mods + (size_t)mrow * 12288; \
    UFOR(j, 8) { \
      const int c = j * 256 + lane * 4; \
      const float4 gg = *(const float4*)(g + c); \
      const float4 s1 = *(const float4*)(ms + scl * DM + c); \
      const float4 s0 = *(const float4*)(ms + sh * DM + c); \
      const float a = V[j].x * rstd * gg.x * (1.f + s1.x) + s0.x; \
      const float b = V[j].y * rstd * gg.y * (1.f + s1.y) + s0.y; \
      const float cc = V[j].z * rstd * gg.z * (1.f + s1.z) + s0.z; \
      const float d = V[j].w * rstd * gg.w * (1.f + s1.w) + s0.w; \
      uint2 o; o.x = pk2(a, b); o.y = pk2(cc, d); \
      *(uint2*)(A + (size_t)rr * DM + c) = o; } }
  int r = bid_ * 8 + wv;
  if (r < nrows) NORM_LOAD(va, r);
  for (; r < nrows; r += 2 * stride) {
    if (r + stride < nrows) NORM_LOAD(vb, r + stride);
    NORM_BODY(va, r);
    if (r + 2 * stride < nrows) NORM_LOAD(va, r + 2 * stride);
    if (r + stride < nrows) NORM_BODY(vb, r + stride);
  }
#undef NORM_LOAD
#undef NORM_BODY
}

__device__ __forceinline__ void phase_final(KP p) {
  const int tid_ = tidx(); const int bid_ = bidx(); (void)bid_;
  p = kp_launder(p);
  const float* g = p->in[26];
  const int lane = tid_ & 63, wv = tid_ >> 6;
  const int stride = gridDim.x * 8;
  float4 va[8], vb[8];
#define FIN_LOAD(V, R_) { const float* s = p->out + (size_t)(R_) * DM; UFOR(j, 8) V[j] = *(const float4*)(s + j * 256 + lane * 4); }
#define FIN_BODY(V, R_) { \
    float* src = p->out + (size_t)(R_) * DM; \
    float ss = 0.f; \
    UFOR(j, 8) ss += V[j].x * V[j].x + V[j].y * V[j].y + V[j].z * V[j].z + V[j].w * V[j].w; \
    ss = wave_sum(ss); \
    const float rstd = rsqrtf(ss * (1.0f / DM) + 1e-6f); \
    UFOR(j, 8) { \
      const int c = j * 256 + lane * 4; \
      const float4 gg = *(const float4*)(g + c); \
      float4 o; o.x = V[j].x * rstd * gg.x; o.y = V[j].y * rstd * gg.y; o.z = V[j].z * rstd * gg.z; o.w = V[j].w * rstd * gg.w; \
      *(float4*)(src + c) = o; } }
  int r = bid_ * 8 + wv;
  if (r < ML) FIN_LOAD(va, r);
  for (; r < ML; r += 2 * stride) {
    if (r + stride < ML) FIN_LOAD(vb, r + stride);
    FIN_BODY(va, r);
    if (r + 2 * stride < ML) FIN_LOAD(va, r + 2 * stride);
    if (r + stride < ML) FIN_BODY(vb, r + stride);
  }
#undef FIN_LOAD
#undef FIN_BODY
}

constexpr int BM = 256, BK = 64, HALF = 128, NXCD = 8, WGM = 8, HT = HALF * BK;
__device__ __forceinline__ int lds_byte(int r, int c) {
  int st = (r >> 4) * 2 + (c >> 5), rr = r & 15, cc = c & 31, ob = rr * 64 + cc * 2;
  return st * 1024 + (ob ^ (((ob >> 9) & 1) << 5));
}
__device__ __forceinline__ void stage_rc(int b, int& R, int& C) {
  int st = b / 1024, sb = b % 1024, swz = sb ^ (((sb >> 9) & 1) << 5);
  R = (st >> 1) * 16 + swz / 64; C = (st & 1) * 32 + (swz % 64) / 2;
}

enum { EPI_Z = 0, EPI_RES = 1, EPI_UPG = 2, EPI_PART = 3 };
struct EpiArgs {
  u16* zrw; u16* zcr;
  const float* srcL; const float* srcC; float* dstL; float* dstC; const float* gate;
  u16* h2; const float* cw;
  float* part;
};

template <int EPI, int K, int KL>
__device__ __forceinline__ void gemm_tile(const u16* __restrict__ A, const u16* __restrict__ Bt, const long brow, const int bcol,
                          const int pn, const int seq0, const int seq1, const EpiArgs& e,
                          const bool own_prologue, const bool has_next, const long nbrow, const int nbcol) {
  const int tid_ = tidx(); const int bid_ = bidx(); (void)bid_;
  u16* shm = (u16*)smem;
#define SA(b, h) (shm + ((b) * 2 + (h)) * HT)
#define SB(b, h) (shm + (4 + (b) * 2 + (h)) * HT)
#define STAGE(P, BASE, br, kt) STAGET(tid_, P, BASE, br, kt)
#define STAGET(TT, P, BASE, br, kt)                                                                              \
  do {                                                                                                      \
    long _g = (long)(br) * K + (long)(kt) * BK;                                                             \
    UFOR(_i, 2) {                                                                        \
      int _b = (TT) * 16 + _i * 8192; int _r, _c; stage_rc(_b, _r, _c);                              \
      __builtin_amdgcn_global_load_lds((const unsigned*)(BASE + _g + (long)_r * K + _c),                    \
                                       (__attribute__((address_space(3))) unsigned*)((char*)(P) + _b), 16, 0, 0); \
    }                                                                                                       \
  } while (0)
#define LDA(dst, b, h) UFOR(m, 4) UFOR(k, 2) \
    dst[m][k] = *reinterpret_cast<const bf16x8*>((char*)SA(b, h) + lds_byte(wr * 64 + m * 16 + fr, k * 32 + fq * 8))
#define LDB(dst, b, h) UFOR(n, 2) UFOR(k, 2) \
    dst[n][k] = *reinterpret_cast<const bf16x8*>((char*)SB(b, h) + lds_byte(wc * 32 + n * 16 + fr, k * 32 + fq * 8))
#define MMA(ai, bj, At, Bq) do { __builtin_amdgcn_s_setprio(1); \
    UFOR(m, 4) UFOR(n, 2) UFOR(k, 2) \
      acc[ai][bj][m][n] = __builtin_amdgcn_mfma_f32_16x16x32_bf16(Bq[n][k], At[m][k], acc[ai][bj][m][n], 0, 0, 0); \
    __builtin_amdgcn_s_setprio(0); } while (0)
#define WAIT_V(n) asm volatile("s_waitcnt vmcnt(" #n ")" ::: "memory")
#define WAIT_L(n) asm volatile("s_waitcnt lgkmcnt(" #n ")" ::: "memory")
#define BAR __builtin_amdgcn_s_barrier()
#define SCHED __builtin_amdgcn_sched_barrier(0)
  const int wid = tid_ >> 6, lane = tid_ & 63, wr = wid >> 2, wc = wid & 3, fr = lane & 15, fq = lane >> 4;
  f32x4 acc[2][2][4][2] = {};
  bf16x8 At[4][2], B0[2][2], B1[2][2];
  const int nt = KL / BK;
  if (own_prologue) {
    STAGE(SB(0, 0), Bt, bcol, 0); STAGE(SA(0, 0), A, brow, 0);
    STAGE(SB(0, 1), Bt, bcol + HALF, 0); STAGE(SA(0, 1), A, brow + HALF, 0);
  }
  if (wr == 1) BAR;
  WAIT_V(4); BAR;
  STAGE(SB(1, 0), Bt, bcol, 1); STAGE(SA(1, 0), A, brow, 1); STAGE(SB(1, 1), Bt, bcol + HALF, 1);
  WAIT_V(6); BAR;
  for (int t = 0; t < nt - 2; t += 2) {
    LDB(B0, 0, 0); SCHED; LDA(At, 0, 0); STAGE(SA(1, 1), A, brow + HALF, t + 1);
    WAIT_L(8); BAR; WAIT_L(0); MMA(0, 0, At, B0); BAR; SCHED;
    LDB(B1, 0, 1); STAGE(SB(0, 0), Bt, bcol, t + 2);
    BAR; WAIT_L(0); MMA(0, 1, At, B1); BAR;
    LDA(At, 0, 1); STAGE(SA(0, 0), A, brow, t + 2);
    BAR; WAIT_L(0); MMA(1, 0, At, B0); BAR; SCHED;
    STAGE(SB(0, 1), Bt, bcol + HALF, t + 2);
    WAIT_V(6); BAR; MMA(1, 1, At, B1); BAR;
    LDB(B0, 1, 0); SCHED; LDA(At, 1, 0); STAGE(SA(0, 1), A, brow + HALF, t + 2);
    WAIT_L(8); BAR; WAIT_L(0); MMA(0, 0, At, B0); BAR; SCHED;
    LDB(B1, 1, 1); STAGE(SB(1, 0), Bt, bcol, t + 3);
    BAR; WAIT_L(0); MMA(0, 1, At, B1); BAR;
    LDA(At, 1, 1); STAGE(SA(1, 0), A, brow, t + 3);
    BAR; WAIT_L(0); MMA(1, 0, At, B0); BAR; SCHED;
    STAGE(SB(1, 1), Bt, bcol + HALF, t + 3);
    WAIT_V(6); BAR; MMA(1, 1, At, B1); BAR;
  }
  { LDB(B0, 0, 0); LDA(At, 0, 0); STAGE(SA(1, 1), A, brow + HALF, nt - 1);
    BAR; WAIT_L(0); MMA(0, 0, At, B0); BAR;
    LDB(B1, 0, 1); BAR; WAIT_L(0); MMA(0, 1, At, B1); BAR;
    LDA(At, 0, 1); WAIT_V(4); BAR; WAIT_L(0); MMA(1, 0, At, B0); MMA(1, 1, At, B1); BAR; }
  { LDB(B0, 1, 0); LDA(At, 1, 0); WAIT_V(2); BAR; WAIT_L(0); MMA(0, 0, At, B0); BAR;
    LDB(B1, 1, 1); WAIT_V(0); BAR; WAIT_L(0); MMA(0, 1, At, B1); BAR;
    LDA(At, 1, 1); BAR; WAIT_L(0); MMA(1, 0, At, B0); MMA(1, 1, At, B1); BAR; }
  if (wr == 0) BAR;
  if (EPI != EPI_UPG && EPI != EPI_PART && has_next) {
    int t2 = tid_; asm volatile("" : "+v"(t2));
    STAGET(t2, SB(0, 0), Bt, nbcol, 0); STAGET(t2, SA(0, 0), A, nbrow, 0);
    STAGET(t2, SB(0, 1), Bt, nbcol + HALF, 0); STAGET(t2, SA(0, 1), A, nbrow + HALF, 0);
  }
  if (EPI == EPI_Z) {
    u16* dst; int ld, c0;
    if (bcol < RWC) { dst = e.zrw; ld = RWC; c0 = bcol; } else { dst = e.zcr; ld = CRC; c0 = bcol - RWC; }
    UFOR(ai, 2) UFOR(bj, 2) UFOR(m, 4) {
      const f32x4 a = acc[ai][bj][m][0], b = acc[ai][bj][m][1];
      uint4 pk; pk.x = pk2(a[0], a[1]); pk.y = pk2(a[2], a[3]); pk.z = pk2(b[0], b[1]); pk.w = pk2(b[2], b[3]);
      *(uint4*)(dst + (size_t)(brow + ai * HALF + wr * 64 + m * 16 + fr) * ld + (c0 + bj * HALF + wc * 32 + fq * 8)) = pk;
    }
  } else if (EPI == EPI_RES) {
    const float* src; float* dst; const float* gt; long r0 = brow;
    if (brow < ML) { src = e.srcL; dst = e.dstL; gt = e.gate + (size_t)(brow >> 14) * 12288; }
    else { src = e.srcC; dst = e.dstC; gt = e.gate + (size_t)2 * 12288; r0 = brow - ML; }
    UFOR(bj, 2) UFOR(n, 2) {
      const int c = bcol + bj * HALF + wc * 32 + fq * 8 + n * 4;
      const float4 gv = *(const float4*)(gt + c);
      UFOR(ai, 2) {
        UFOR(m, 4) {
          const size_t idx = (size_t)(r0 + ai * HALF + wr * 64 + m * 16 + fr) * DM + c;
          float4 s = *(const float4*)(src + idx);
          const f32x4 a = acc[ai][bj][m][n];
          s.x += gv.x * a[0]; s.y += gv.y * a[1]; s.z += gv.z * a[2]; s.w += gv.w * a[3];
          *(float4*)(dst + idx) = s;
        }
        __builtin_amdgcn_sched_barrier(0);
      }
    }
  } else if (EPI == EPI_PART) {
    const long r0 = brow - ML;
    UFOR(ai, 2) UFOR(bj, 2) UFOR(m, 4) UFOR(n, 2) {
      const f32x4 a = acc[ai][bj][m][n];
      *(float4*)(e.part + (size_t)(r0 + ai * HALF + wr * 64 + m * 16 + fr) * DM + (bcol + bj * HALF + wc * 32 + fq * 8 + n * 4)) = make_float4(a[0], a[1], a[2], a[3]);
    }
  } else {
    u16* U = (u16*)smem;
    LDS_BARRIER();
    UFOR(ai, 2) UFOR(bj, 2) UFOR(m, 4) {
      const f32x4 a = acc[ai][bj][m][0], b = acc[ai][bj][m][1];
      uint4 pk; pk.x = pk2(a[0], a[1]); pk.y = pk2(a[2], a[3]); pk.z = pk2(b[0], b[1]); pk.w = pk2(b[2], b[3]);
      *(uint4*)(U + (ai * HALF + wr * 64 + m * 16 + fr) * 256 + bj * 128 + wc * 32 + fq * 8) = pk;
    }
    LDS_BARRIER();
    {
      const int c4 = (tid_ & 31) * 4, rb = tid_ >> 5;
      const int gc = pn * 128 + c4;
      float wg[4][3], wv[4][3];
      UFOR(q, 4) UFOR(x, 3) { wg[q][x] = e.cw[(size_t)(gc + q) * 3 + x]; wv[q][x] = e.cw[(size_t)(DFF + gc + q) * 3 + x]; }
      float pg[4], cgv[4], ng[4], pvv[4], cv[4], nv[4];
      const int lr0 = rb * 16;
      {
        const int lrp = lr0 > 0 ? lr0 - 1 : 0;
        const uint2 a = *(const uint2*)(U + lrp * 256 + c4), b = *(const uint2*)(U + lrp * 256 + 128 + c4);
        pg[0] = lo2f(a.x); pg[1] = hi2f(a.x); pg[2] = lo2f(a.y); pg[3] = hi2f(a.y);
        pvv[0] = lo2f(b.x); pvv[1] = hi2f(b.x); pvv[2] = lo2f(b.y); pvv[3] = hi2f(b.y);
        const uint2 c = *(const uint2*)(U + lr0 * 256 + c4), d = *(const uint2*)(U + lr0 * 256 + 128 + c4);
        cgv[0] = lo2f(c.x); cgv[1] = hi2f(c.x); cgv[2] = lo2f(c.y); cgv[3] = hi2f(c.y);
        cv[0] = lo2f(d.x); cv[1] = hi2f(d.x); cv[2] = lo2f(d.y); cv[3] = hi2f(d.y);
      }
#pragma unroll 2
      for (int q = 0; q < 16; ++q) {
        const int lr = lr0 + q;
        const int lrn = lr < 255 ? lr + 1 : 255;
        const uint2 a = *(const uint2*)(U + lrn * 256 + c4), b = *(const uint2*)(U + lrn * 256 + 128 + c4);
        ng[0] = lo2f(a.x); ng[1] = hi2f(a.x); ng[2] = lo2f(a.y); ng[3] = hi2f(a.y);
        nv[0] = lo2f(b.x); nv[1] = hi2f(b.x); nv[2] = lo2f(b.y); nv[3] = hi2f(b.y);
        const long gr = brow + lr;
        const bool valid = (gr >= seq0) && (gr < seq1) && (lr >= 1 || gr == seq0) && (lr <= 254 || gr == seq1 - 1);
        if (valid) {
          const float mp = (gr - 1 >= seq0) ? 1.f : 0.f, mn = (gr + 1 < seq1) ? 1.f : 0.f;
          float o[4];
          UFOR(x, 4) {
            const float g = wg[x][0] * pg[x] * mp + wg[x][1] * cgv[x] + wg[x][2] * ng[x] * mn;
            const float v = wv[x][0] * pvv[x] * mp + wv[x][1] * cv[x] + wv[x][2] * nv[x] * mn;
            o[x] = siluf_(g) * v;
          }
          uint2 pk; pk.x = pk2(o[0], o[1]); pk.y = pk2(o[2], o[3]);
          *(uint2*)(e.h2 + (size_t)gr * DFF + gc) = pk;
        }
        UFOR(x, 4) { pg[x] = cgv[x]; cgv[x] = ng[x]; pvv[x] = cv[x]; cv[x] = nv[x]; }
      }
    }
    LDS_BARRIER();
    if (has_next) {
      int t2 = tid_; asm volatile("" : "+v"(t2));
      STAGET(t2, SB(0, 0), Bt, nbcol, 0); STAGET(t2, SA(0, 0), A, nbrow, 0);
      STAGET(t2, SB(0, 1), Bt, nbcol + HALF, 0); STAGET(t2, SA(0, 1), A, nbrow + HALF, 0);
    }
  }
#undef SA
#undef SB
}

template <int EPI>
__device__ __forceinline__ void tile_coords(int L, int nM, int nN, long& brow, int& pn, int& seq0, int& seq1) {
  const int nwg = nM * nN;
  int wgid = L;
  { const int q = nwg / NXCD, r = nwg % NXCD, xcd = wgid % NXCD, off = wgid / NXCD; wgid = (xcd < r ? xcd * (q + 1) : r * (q + 1) + (xcd - r) * q) + off; }
  const int nig = WGM * nN, gid = wgid / nig, fm = gid * WGM, gsz = (nM - fm) < WGM ? (nM - fm) : WGM;
  const int pm = fm + ((wgid % nig) % gsz);
  pn = (wgid % nig) / gsz;
  seq0 = 0; seq1 = 0;
  if (EPI == EPI_UPG) {
    if (pm < 130) { const int s = pm / 65, i = pm % 65; seq0 = s * TL; seq1 = seq0 + TL; brow = seq0 + 254 * i - 1; }
    else { const int s = pm - 130; seq0 = ML + s * CTX; seq1 = seq0 + CTX; brow = seq0; }
  } else brow = (long)pm * BM;
}
template <int EPI, int K>
__device__ __forceinline__ void gemm_phase(const u16* A, const u16* Bt, int nM, int nN, const EpiArgs& e) {
  const int tid_ = tidx(); const int bid_ = bidx(); (void)bid_; (void)tid_;
  const int nwg = nM * nN, G = gridDim.x;
  long brow = 0, nbrow = 0; int pn = 0, seq0 = 0, seq1 = 0, npn = 0, nseq0 = 0, nseq1 = 0;
  if (bid_ < nwg) tile_coords<EPI>(bid_, nM, nN, brow, pn, seq0, seq1);
  bool first = true;
  for (int L = bid_; L < nwg; L += G) {
    const bool has_next = (L + G) < nwg;
    if (has_next) tile_coords<EPI>(L + G, nM, nN, nbrow, npn, nseq0, nseq1);
    gemm_tile<EPI, K, K>(A, Bt, brow, pn * BM, pn, seq0, seq1, e, first, has_next, nbrow, npn * BM);
    first = false;
    brow = nbrow; pn = npn; seq0 = nseq0; seq1 = nseq1;
  }
  __syncthreads();
}

#define OFF_P2 (832 * MIB)
#define P2_PARTS 11
__device__ __forceinline__ void gemm_ctx_splitk_down(const u16* A, const u16* Bt, float* P2, const EpiArgs& e0) {
  const int tid_ = tidx(); const int bid_ = bidx(); (void)tid_;
  for (int u = bid_; u < 16 * P2_PARTS; u += gridDim.x) {
    const int tile = u / P2_PARTS, part = u % P2_PARTS, pm = 128 + (tile >> 3), pn = tile & 7;
    EpiArgs e = e0; e.part = P2 + (size_t)part * 512 * DM;
    const long koff = (long)part * (DFF / P2_PARTS);
    gemm_tile<EPI_PART, DFF, DFF / P2_PARTS>(A + koff, Bt + koff, (long)pm * BM, pn * BM, pn, 0, 0, e, true, false, 0, 0);
  }
  __syncthreads();
}

#define R_QS 0
#define R_KS 17408
#define R_KT 34816
#define R_VT 53248
#define R_SS 71680
#define R_RT 80896
#define R_KT2 34816
#define R_KT2B 71680
__device__ __forceinline__ float lg_gamma(int h, int dir) { return log1pf(-exp2f(-(dir ? 5.5f : 5.0f) - (float)h)); }

__device__ __forceinline__ bf16x8 ldsfrag(int base, int row, int ldb, int kel) {
  return *(const bf16x8*)(smem + base + row * ldb + kel * 2);
}
#define MFMA16(a, b, c) __builtin_amdgcn_mfma_f32_16x16x32_bf16(a, b, c, 0, 0, 0)
__device__ __forceinline__ bf16x8 ldsfrag_sw(int base, int row, int ks, int fq) {
  return *(const bf16x8*)(smem + base + row * 144 + ((((ks << 2) | fq) ^ ((row >> 3) & 7)) << 4));
}
#define LDSFRAG_SWN(base, N, ks, pl0, pl1, rowoff) \
  (*(const bf16x8*)(smem + (base) + (rowoff) + (N) * 2304 + ((((ks) ^ (((N) >> 1) & 1)) << 6)) + (((N) & 1) ? (pl1) : (pl0))))

#define R_TAB 115712
struct RetRaw { uint4 q1, q2, k1, k2, v1, v2; float4 c0, c1, s0, s1; };
__device__ __forceinline__ void ret_issue(KP p, RetRaw& R, int tid_, int mode, int base, int rev, int h, int rope, int t0) {
  const u16* zcr = (const u16*)(p->ws + OFF_ZCR);
  const float* rc = (const float*)(p->ws + OFF_ROPE);
  const float* rs = rc + TL * 64;
  const int i = tid_ >> 3, g = tid_ & 7;
  const int nr = rev ? (base + 63 - i) : (base + i);
  const u16* zr = zcr + (size_t)nr * CRC + 1536 + h * 128;
  R.k1 = *(const uint4*)(zr + 768 + g * 8); R.k2 = *(const uint4*)(zr + 768 + 64 + g * 8);
  R.v1 = *(const uint4*)(zr + 1536 + g * 8); R.v2 = *(const uint4*)(zr + 1536 + 64 + g * 8);
  if (mode == 0) { R.q1 = *(const uint4*)(zr + g * 8); R.q2 = *(const uint4*)(zr + 64 + g * 8); }
  if (rope) {
    const int t = t0 + (rev ? (63 - i) : i);
    const float* cp = rc + (size_t)t * 64 + g * 8; const float* sp = rs + (size_t)t * 64 + g * 8;
    R.c0 = *(const float4*)cp; R.c1 = *(const float4*)(cp + 4); R.s0 = *(const float4*)sp; R.s1 = *(const float4*)(sp + 4);
  }
}
__device__ __forceinline__ void ret_stage(const RetRaw& R, int tid_, int mode, int rope, float zf, float zb) {
  const int i = tid_ >> 3, g = tid_ & 7;
  float q1[8], q2[8], k1[8], k2[8], v1[8], v2[8];
  unpack8(R.k1, k1); unpack8(R.k2, k2); unpack8(R.v1, v1); unpack8(R.v2, v2);
  if (mode == 0) { unpack8(R.q1, q1); unpack8(R.q2, q2); }
  if (rope) {
    const float cc[8] = {R.c0.x, R.c0.y, R.c0.z, R.c0.w, R.c1.x, R.c1.y, R.c1.z, R.c1.w};
    const float ss[8] = {R.s0.x, R.s0.y, R.s0.z, R.s0.w, R.s1.x, R.s1.y, R.s1.z, R.s1.w};
    UFOR(x, 8) {
      const float c = cc[x], s = ss[x];
      const float a = k1[x], b = k2[x]; k1[x] = a * c - b * s; k2[x] = a * s + b * c;
      if (mode == 0) { const float a2 = q1[x], b2 = q2[x]; q1[x] = a2 * c - b2 * s; q2[x] = a2 * s + b2 * c; }
    }
  }
  u16* VT = (u16*)(smem + R_VT);
  const int isw = i ^ (g << 3);
  UFOR(x, 8) { VT[(g * 8 + x) * 72 + isw] = f2bf(v1[x]); VT[(64 + g * 8 + x) * 72 + isw] = f2bf(v2[x]); }
  u16* KT = (u16*)(smem + R_KT);
  UFOR(x, 8) { KT[(g * 8 + x) * 72 + isw] = f2bf(k1[x] * zf); KT[(64 + g * 8 + x) * 72 + isw] = f2bf(k2[x] * zf); }
  if (mode == 1) {
    u16* KB = (u16*)(smem + R_KT2B);
    UFOR(x, 8) { KB[(g * 8 + x) * 72 + isw] = f2bf(k1[x] * zb); KB[(64 + g * 8 + x) * 72 + isw] = f2bf(k2[x] * zb); }
  } else {
    const float sc = 0.08838834764831845f;
    UFOR(x, 8) { q1[x] *= sc; q2[x] *= sc; }
    *(uint4*)(smem + R_QS + i * 272 + g * 16) = pack8(q1); *(uint4*)(smem + R_QS + i * 272 + 128 + g * 16) = pack8(q2);
    *(uint4*)(smem + R_KS + i * 272 + g * 16) = pack8(k1); *(uint4*)(smem + R_KS + i * 272 + 128 + g * 16) = pack8(k2);
  }
}

#define NSEG 21
__device__ __forceinline__ int seg_c0(int s) { return (s * 256) / NSEG; }
__device__ __forceinline__ void phase_ret_summaries(KP p) {
  const int tid_ = tidx(); const int bid_ = bidx(); (void)bid_;
  p = kp_launder(p);
  float* KV = (float*)(p->ws + OFF_KV);
  const int lane = tid_ & 63, w = tid_ >> 6, fr = lane & 15, fq = lane >> 4;
  const int ti = tid_ >> 3;
  const int pl0 = fr * 144 + ((fq ^ (fr >> 3)) << 4), pl1 = fr * 144 + (((fq ^ (fr >> 3)) ^ 2) << 4);
  int it_step = gridDim.x;
  if ((int)gridDim.x > 12 * NSEG) it_step = (bid_ >= 12 * NSEG) ? ((int)gridDim.x - 12 * NSEG) : 12 * (NSEG + 1);
  for (int it = bid_; it < 12 * (NSEG + 1); it += it_step) {
    int bh, seg;
    if (it < 12 * NSEG) { bh = it / NSEG; seg = it % NSEG; } else { bh = it - 12 * NSEG; seg = NSEG; }
    const int b = bh / 6, h = bh % 6;
    const int isctx = seg == NSEG;
    const int c0 = seg_c0(seg), tseg0 = c0 * 64;
    const int L = isctx ? CTX : (seg_c0(seg + 1) - c0) * 64;
    const int n0 = isctx ? (ML + b * CTX) : (b * TL + tseg0);
    const float lgf = lg_gamma(h, 0), lgb = lg_gamma(h, 1);
    f32x4 af[8], ab[8];
    UFOR(n, 8) { af[n] = (f32x4){0.f, 0.f, 0.f, 0.f}; ab[n] = af[n]; }
    RetRaw R;
    ret_issue(p, R, tid_, 1, n0, 0, h, !isctx, tseg0);
    const int nsc = L / 64;
    for (int sc = 0; sc < nsc; ++sc) {
      LDS_BARRIER();
      ret_stage(R, tid_, 1, !isctx, expf(lgf * (float)(L - 1 - sc * 64 - ti)), expf(lgb * (float)(sc * 64 + ti)));
      if (sc + 1 < nsc) ret_issue(p, R, tid_, 1, n0 + (sc + 1) * 64, 0, h, !isctx, tseg0 + (sc + 1) * 64);
      LDS_BARRIER();
      UFOR(ks, 2) {
        const bf16x8 a = ldsfrag_sw(R_VT, w * 16 + fr, ks, fq);
        UFOR(n, 8) {
          af[n] = MFMA16(LDSFRAG_SWN(R_KT, n, ks, pl0, pl1, 0), a, af[n]);
          ab[n] = MFMA16(LDSFRAG_SWN(R_KT2B, n, ks, pl0, pl1, 0), a, ab[n]);
        }
      }
    }
    f32x4* of = (f32x4*)(KV + (((size_t)(bh * 2 + 0) * (NSEG + 1) + seg) * 512 + tid_) * 32);
    f32x4* ob = (f32x4*)(KV + (((size_t)(bh * 2 + 1) * (NSEG + 1) + seg) * 512 + tid_) * 32);
    UFOR(n, 8) { of[n] = af[n]; ob[n] = ab[n]; }
  }
}

__device__ __forceinline__ void ret_pass(KP p, int tid_, int dir, int n0, int nch, int h, int rope, int tseg0, f32x4* RT, float* scr) {
  const int lane = tid_ & 63, w = tid_ >> 6, fr = lane & 15, fq = lane >> 4;
  const int mt = w >> 1, nh = w & 1;
  const int pl0 = fr * 144 + ((fq ^ (fr >> 3)) << 4), pl1 = fr * 144 + (((fq ^ (fr >> 3)) ^ 2) << 4);
  const float* pw = (const float*)(smem + R_TAB) + dir * 65;
  const float g64 = pw[64];
  RetRaw R;
  { const int nc0 = dir ? (nch - 1) : 0; ret_issue(p, R, tid_, 0, n0 + nc0 * 64, dir, h, rope, tseg0 + nc0 * 64); }
  for (int cc = 0; cc < nch; ++cc) {
    const int nc = dir ? (nch - 1 - cc) : cc;
    LDS_BARRIER();
    UFOR(n, 8) {
      uint2 pk; pk.x = pk2(RT[n][0], RT[n][1]); pk.y = pk2(RT[n][2], RT[n][3]);
      *(uint2*)(smem + R_RT + (w * 16 + fr) * 272 + (n * 16 + fq * 4) * 2) = pk;
    }
    ret_stage(R, tid_, 0, rope, pw[63 - (tid_ >> 3)], 0.f);
    if (cc + 1 < nch) { const int nn = dir ? (nch - 2 - cc) : (cc + 1); ret_issue(p, R, tid_, 0, n0 + nn * 64, dir, h, rope, tseg0 + nn * 64); }
    float yprev[4][4];
    if (!dir) {
      UFOR(n, 4) UFOR(j, 4) { const int i = mt * 16 + fq * 4 + j; yprev[n][j] = scr[(size_t)(nc * 64 + i) * 128 + (nh * 4 + n) * 16 + fr]; }
    }
    LDS_BARRIER();
    f32x4 s[2] = {(f32x4){0.f, 0.f, 0.f, 0.f}, (f32x4){0.f, 0.f, 0.f, 0.f}};
    UFOR(ks, 4) {
      const bf16x8 a = ldsfrag(R_QS, mt * 16 + fr, 272, ks * 32 + fq * 8);
      UFOR(n, 2) s[n] = MFMA16(a, ldsfrag(R_KS, (nh * 2 + n) * 16 + fr, 272, ks * 32 + fq * 8), s[n]);
    }
    UFOR(n, 2) UFOR(j, 4) {
      const int i = mt * 16 + fq * 4 + j, m = (nh * 2 + n) * 16 + fr;
      const int df = i - m;
      float v = 0.f;
      if (dir ? (df > 0) : (df >= 0)) v = s[n][j] * pw[df];
      *(u16*)(smem + R_SS + i * 144 + m * 2) = f2bf(v);
    }
    f32x4 y[4];
    UFOR(n, 4) y[n] = (f32x4){0.f, 0.f, 0.f, 0.f};
    UFOR(ks, 4) {
      const bf16x8 a = ldsfrag(R_QS, mt * 16 + fr, 272, ks * 32 + fq * 8);
      UFOR(n, 4) y[n] = MFMA16(a, ldsfrag(R_RT, (nh * 4 + n) * 16 + fr, 272, ks * 32 + fq * 8), y[n]);
    }
    UFOR(j, 4) {
      const float xi = pw[mt * 16 + fq * 4 + j + 1];
      UFOR(n, 4) y[n][j] *= xi;
    }
    LDS_BARRIER();
    UFOR(ks, 2) {
      const bf16x8 a = ldsfrag(R_SS, mt * 16 + fr, 144, ks * 32 + fq * 8);
      UFOR(n, 4) y[n] = MFMA16(a, LDSFRAG_SWN(R_VT, n, ks, pl0, pl1, nh * 9216), y[n]);
    }
    UFOR(n, 8) UFOR(j, 4) RT[n][j] *= g64;
    UFOR(ks, 2) {
      const bf16x8 a = ldsfrag_sw(R_VT, w * 16 + fr, ks, fq);
      UFOR(n, 8) RT[n] = MFMA16(LDSFRAG_SWN(R_KT, n, ks, pl0, pl1, 0), a, RT[n]);
    }
    UFOR(n, 4) UFOR(j, 4) {
      const int i = mt * 16 + fq * 4 + j;
      const int tl = nc * 64 + (dir ? (63 - i) : i);
      float* d = scr + (size_t)tl * 128 + (nh * 4 + n) * 16 + fr;
      if (dir) *d = y[n][j]; else *d = y[n][j] + yprev[n][j];
    }
  }
}

__device__ __forceinline__ void phase_ret_out(KP p, int l, int with_ctx) {
  const int tid_ = tidx(); const int bid_ = bidx(); (void)bid_;
  p = kp_launder(p);
  const float* KV = (const float*)(p->ws + OFF_KV);
  float* scr = (float*)(p->ws + OFF_SCR) + (size_t)bid_ * 106496;
  u16* mix = (u16*)(p->ws + OFF_A);
  const u16* zcr = (const u16*)(p->ws + OFF_ZCR);
  const float* rng = p->in[21] + (size_t)l * RW;
  const int lane = tid_ & 63, w = tid_ >> 6;
  const int nitems = 12 * (with_ctx ? NSEG + 1 : NSEG);
  int it_step = gridDim.x;
  if ((int)gridDim.x > 12 * NSEG) it_step = (bid_ >= 12 * NSEG) ? ((int)gridDim.x - 12 * NSEG) : 12 * (NSEG + 1);
  for (int it = bid_; it < nitems; it += it_step) {
    int bh, seg;
    if (it < 12 * NSEG) { bh = it / NSEG; seg = it % NSEG; } else { bh = it - 12 * NSEG; seg = NSEG; }
    const int b = bh / 6, h = bh % 6;
    const int isctx = seg == NSEG;
    const int c0 = seg_c0(seg), tseg0 = c0 * 64;
    const int nch = isctx ? 4 : (seg_c0(seg + 1) - c0);
    const int n0 = isctx ? (ML + b * CTX) : (b * TL + tseg0);
    const float lgf = lg_gamma(h, 0), lgb = lg_gamma(h, 1);
    __syncthreads();
    if (tid_ < 130) { const int d = tid_ / 65, e = tid_ % 65; ((float*)(smem + R_TAB))[tid_] = expf((d ? lgb : lgf) * (float)e); }
    __syncthreads();
    f32x4 RT[8];
    UFOR(n, 8) RT[n] = (f32x4){0.f, 0.f, 0.f, 0.f};
    if (!isctx) {
      const float g12 = expf(lgb * 768.f), g13 = expf(lgb * 832.f);
      const f32x4* base = (const f32x4*)(KV + ((size_t)(bh * 2 + 1) * (NSEG + 1) * 512 + tid_) * 32);
      UFOR(n, 8) RT[n] = base[(size_t)NSEG * 4096 + n];
#pragma unroll 2
      for (int s = NSEG - 1; s > seg; --s) {
        f32x4 t[8];
        UFOR(n, 8) t[n] = base[(size_t)s * 4096 + n];
        const float gL = (seg_c0(s + 1) - seg_c0(s)) == 13 ? g13 : g12;
        UFOR(n, 8) RT[n] = RT[n] * gL + t[n];
      }
    }
    ret_pass(p, tid_, 1, n0, nch, h, !isctx, tseg0, RT, scr);
    __syncthreads();
    UFOR(n, 8) RT[n] = (f32x4){0.f, 0.f, 0.f, 0.f};
    if (!isctx) {
      const float g12 = expf(lgf * 768.f), g13 = expf(lgf * 832.f);
      const f32x4* base = (const f32x4*)(KV + ((size_t)(bh * 2 + 0) * (NSEG + 1) * 512 + tid_) * 32);
      UFOR(n, 8) RT[n] = base[(size_t)NSEG * 4096 + n];
#pragma unroll 2
      for (int s = 0; s < seg; ++s) {
        f32x4 t[8];
        UFOR(n, 8) t[n] = base[(size_t)s * 4096 + n];
        const float gL = (seg_c0(s + 1) - seg_c0(s)) == 13 ? g13 : g12;
        UFOR(n, 8) RT[n] = RT[n] * gL + t[n];
      }
    }
    ret_pass(p, tid_, 0, n0, nch, h, !isctx, tseg0, RT, scr);
    __syncthreads();
    {
      const int ntw = nch * 8;
      const float rg0 = rng[h * 128 + lane], rg1 = rng[h * 128 + 64 + lane];
      for (int k0 = 0; k0 < ntw; k0 += 8) {
        float v0[8], v1[8]; u16 g0[8], g1[8];
        UFOR(u, 8) {
          const int tl = w * ntw + k0 + u;
          const size_t row = (size_t)(n0 + tl);
          v0[u] = scr[(size_t)tl * 128 + lane]; v1[u] = scr[(size_t)tl * 128 + 64 + lane];
          g0[u] = zcr[row * CRC + 1536 + 2304 + h * 128 + lane]; g1[u] = zcr[row * CRC + 1536 + 2304 + h * 128 + 64 + lane];
        }
        UFOR(u, 8) {
          const int tl = w * ntw + k0 + u;
          const size_t row = (size_t)(n0 + tl);
          const float mu = wave_sum(v0[u] + v1[u]) * (1.f / 128.f);
          const float d0 = v0[u] - mu, d1 = v1[u] - mu;
          const float var = wave_sum(d0 * d0 + d1 * d1) * (1.f / 128.f);
          const float rstd = rsqrtf(var + 1e-6f);
          mix[row * DM + 1280 + h * 128 + lane] = f2bf(siluf_(bf2f(g0[u])) * d0 * rstd * rg0);
          mix[row * DM + 1280 + h * 128 + 64 + lane] = f2bf(siluf_(bf2f(g1[u])) * d1 * rstd * rg1);
        }
      }
    }
    __syncthreads();
  }
}

__device__ __forceinline__ void phase_convmix(KP p, int l, int nrows) {
  const int tid_ = tidx(); const int bid_ = bidx(); (void)bid_;
  p = kp_launder(p);
  const u16* zcr = (const u16*)(p->ws + OFF_ZCR);
  u16* mix = (u16*)(p->ws + OFF_A);
  const float* cw = p->in[20] + (size_t)l * 512 * 3;
  const int total = nrows * 64;
  for (int i = bid_ * NTHREADS + tid_; i < total; i += gridDim.x * NTHREADS) {
    const int r = i >> 6, c = (i & 63) * 8;
    int s0, len, mr; seqinfo(r, s0, len, mr);
    const u16* z = zcr + (size_t)r * CRC;
    float gb[8], cc[8], hh[8], pm[8], pp[8], t1[8], t2[8];
    unpack8(*(const uint4*)(z + c), gb);
    unpack8(*(const uint4*)(z + 512 + c), cc); unpack8(*(const uint4*)(z + 1024 + c), hh);
    UFOR(x, 8) { cc[x] *= hh[x]; pm[x] = 0.f; pp[x] = 0.f; }
    if (r - 1 >= s0) { unpack8(*(const uint4*)(z - CRC + 512 + c), t1); unpack8(*(const uint4*)(z - CRC + 1024 + c), t2); UFOR(x, 8) pm[x] = t1[x] * t2[x]; }
    if (r + 1 < s0 + len) { unpack8(*(const uint4*)(z + CRC + 512 + c), t1); unpack8(*(const uint4*)(z + CRC + 1024 + c), t2); UFOR(x, 8) pp[x] = t1[x] * t2[x]; }
    float o[8];
    UFOR(x, 8) o[x] = gb[x] * (pm[x] * cw[(c + x) * 3] + cc[x] * cw[(c + x) * 3 + 1] + pp[x] * cw[(c + x) * 3 + 2]);
    *(uint4*)(mix + (size_t)r * DM + 768 + c) = pack8(o);
  }
}

#define FA(i) ((u16*)(p->ws + OFF_FEAT + (size_t)(i) * FEAT_SZ))
#define F_AIN 0
#define F_KL 8448
#define F_KK 33024
#define F_RL 57600
#define F_SB 82176
#define F_STG 82944
__device__ __forceinline__ uint4 packh8(const float* f) {
  uint4 u;
  u.x = (unsigned)f2h(f[0]) | ((unsigned)f2h(f[1]) << 16); u.y = (unsigned)f2h(f[2]) | ((unsigned)f2h(f[3]) << 16);
  u.z = (unsigned)f2h(f[4]) | ((unsigned)f2h(f[5]) << 16); u.w = (unsigned)f2h(f[6]) | ((unsigned)f2h(f[7]) << 16);
  return u;
}
__device__ __forceinline__ void ld8f(const float* p_, float* f) {
  const float4 a = *(const float4*)p_, b = *(const float4*)(p_ + 4);
  f[0] = a.x; f[1] = a.y; f[2] = a.z; f[3] = a.w; f[4] = b.x; f[5] = b.y; f[6] = b.z; f[7] = b.w;
}
__device__ __forceinline__ void phase_features(KP p, int l) {
  const int tid_ = tidx(); const int bid_ = bidx(); (void)bid_;
  p = kp_launder(p);
  const u16* zrw = (const u16*)(p->ws + OFF_ZRW);
  const float* mu = p->in[9] + (size_t)l * RWC;
  const u16* lora = (const u16*)(p->ws + OFF_LORA) + (size_t)l * LORA_L;
  const u16* wupT = lora; const u16* aupT = lora + 98304; const u16* gupT = lora + 196608;
  const float* w0 = p->in[10] + (size_t)l * 2 * RW; const float* a0 = p->in[12] + (size_t)l * 2 * RW;
  const float* kk_ = p->in[15] + (size_t)l * RW; const float* ka_ = p->in[16] + (size_t)l * RW; const float* rk_ = p->in[17] + (size_t)l * RW;
  float* sb = (float*)(p->ws + OFF_SB);
  float* sbl = (float*)(smem + F_SB);
  const int lane = tid_ & 63, w = tid_ >> 6, fr = lane & 15, fq = lane >> 4;
  for (int it = bid_; it < MT / 16; it += gridDim.x) {
    const int R0 = it * 16;
    int s0, len, mr; seqinfo(R0, s0, len, mr);
    LDS_BARRIER();
    if (tid_ < 192) sbl[tid_] = 0.f;
#pragma unroll 9
    for (int i = 0; i < 9; ++i) {
      const int q = tid_ + 512 * i, tok = q / 288, grp = q % 288, sec = grp / 96, r = R0 + tok, col = grp * 8, ch = col - sec * RW;
      const bool hm = r - 1 >= s0, hp = r + 1 < s0 + len;
      const u16* z = zrw + (size_t)r * RWC + col;
      float c[8], a[8], b[8], o[8], m[8];
      unpack8(*(const uint4*)z, c);
      if (hm) unpack8(*(const uint4*)(z - RWC), a); else UFOR(x, 8) a[x] = 0.f;
      if (hp) unpack8(*(const uint4*)(z + RWC), b); else UFOR(x, 8) b[x] = 0.f;
      ld8f(mu + col, m);
      UFOR(x, 8) o[x] = c[x] + (0.5f * (a[x] + b[x]) - c[x]) * m[x];
      const uint4 pk = pack8(o);
      const size_t go = (size_t)r * RW + ch;
      if (sec == 0) { *(uint4*)(FA(0) + go) = pk; *(uint4*)(smem + F_RL + (tok * RW + ch) * 2) = pk; }
      else if (sec == 2) { *(uint4*)(FA(2) + go) = pk; }
      else {
        *(uint4*)(smem + F_KL + (tok * RW + ch) * 2) = pk;
        float kc[8], kq[8]; ld8f(kk_ + ch, kc);
        float ss = 0.f;
        UFOR(x, 8) { kq[x] = o[x] * kc[x]; ss += kq[x] * kq[x]; }
        ss += dppf<0xB1>(ss); ss += dppf<0x4E>(ss); ss += dppf<0x141>(ss);
        const float inv = 1.f / fmaxf(sqrtf(ss), 1e-12f);
        UFOR(x, 8) kq[x] *= inv;
        const uint4 pq = pack8(kq);
        *(uint4*)(FA(1) + go) = pq; *(uint4*)(smem + F_KK + (tok * RW + ch) * 2) = pq;
      }
    }
    {
      const int tok = tid_ >> 5, cg = tid_ & 31, r = R0 + tok;
      const bool hm = r - 1 >= s0, hp = r + 1 < s0 + len;
      const u16* z = zrw + (size_t)r * RWC + 2304 + cg * 8;
      float c[8], a[8], b[8], o[8], m[8];
      unpack8(*(const uint4*)z, c);
      if (hm) unpack8(*(const uint4*)(z - RWC), a); else UFOR(x, 8) a[x] = 0.f;
      if (hp) unpack8(*(const uint4*)(z + RWC), b); else UFOR(x, 8) b[x] = 0.f;
      ld8f(mu + 2304 + cg * 8, m);
      UFOR(x, 8) {
        const float v = c[x] + (0.5f * (a[x] + b[x]) - c[x]) * m[x];
        o[x] = (cg < 8) ? (1.f - 2.f / (1.f + __expf(2.f * v))) : ((cg < 16) ? v : sigmoidf_(v));
      }
      *(uint4*)(smem + F_AIN + tok * 528 + cg * 16) = pack8(o);
    }
    LDS_BARRIER();
    char* stg = smem + F_STG + w * 7168;
    for (int u = w * 3; u < w * 3 + 3; ++u) {
      const int hd = u >> 1, chb = hd * 64 + (u & 1) * 32;
      f32x4 aw0[2], aw1[2], aa0[2], aa1[2], ag[2];
      UFOR(n, 2) { aw0[n] = (f32x4){0.f, 0.f, 0.f, 0.f}; aw1[n] = aw0[n]; aa0[n] = aw0[n]; aa1[n] = aw0[n]; ag[n] = aw0[n]; }
      UFOR(ks, 2) {
        const bf16x8 atw = *(const bf16x8*)(smem + F_AIN + fr * 528 + (ks * 32 + fq * 8) * 2);
        const bf16x8 aad = *(const bf16x8*)(smem + F_AIN + fr * 528 + (64 + ks * 32 + fq * 8) * 2);
        UFOR(n, 2) {
          const int ch = chb + n * 16 + fr;
          aw0[n] = MFMA16(atw, *(const bf16x8*)(wupT + (size_t)ch * 64 + ks * 32 + fq * 8), aw0[n]);
          aw1[n] = MFMA16(atw, *(const bf16x8*)(wupT + (size_t)(RW + ch) * 64 + ks * 32 + fq * 8), aw1[n]);
          aa0[n] = MFMA16(aad, *(const bf16x8*)(aupT + (size_t)ch * 64 + ks * 32 + fq * 8), aa0[n]);
          aa1[n] = MFMA16(aad, *(const bf16x8*)(aupT + (size_t)(RW + ch) * 64 + ks * 32 + fq * 8), aa1[n]);
        }
      }
      UFOR(ks, 4) {
        const bf16x8 asg = *(const bf16x8*)(smem + F_AIN + fr * 528 + (128 + ks * 32 + fq * 8) * 2);
        UFOR(n, 2) {
          const int ch = chb + n * 16 + fr;
          ag[n] = MFMA16(asg, *(const bf16x8*)(gupT + (size_t)ch * 128 + ks * 32 + fq * 8), ag[n]);
        }
      }
      UFOR(n, 2) UFOR(j, 4) {
        const int e = (fq * 4 + j) * 32 + n * 16 + fr;
        ((float*)stg)[e] = aw0[n][j]; ((float*)(stg + 2048))[e] = aw1[n][j];
        ((u16*)(stg + 4096))[e] = f2bf(aa0[n][j]); ((u16*)(stg + 5120))[e] = f2bf(aa1[n][j]); ((u16*)(stg + 6144))[e] = f2bf(ag[n][j]);
      }
      asm volatile("s_waitcnt lgkmcnt(0)" ::: "memory");
      {
        const int tok = lane >> 2, g4 = lane & 3, ch = chb + g4 * 8, r = R0 + tok;
        float xw0[8], xw1[8], ya0[8], ya1[8], gg[8], kv[8], kkn[8], rr[8], cw0[8], cw1[8], ca0[8], ca1[8], cka[8], crk[8];
        ld8f((const float*)stg + tok * 32 + g4 * 8, xw0); ld8f((const float*)(stg + 2048) + tok * 32 + g4 * 8, xw1);
        unpack8(*(const uint4*)(stg + 4096 + (tok * 32 + g4 * 8) * 2), ya0); unpack8(*(const uint4*)(stg + 5120 + (tok * 32 + g4 * 8) * 2), ya1);
        unpack8(*(const uint4*)(stg + 6144 + (tok * 32 + g4 * 8) * 2), gg);
        unpack8(*(const uint4*)(smem + F_KL + (tok * RW + ch) * 2), kv); unpack8(*(const uint4*)(smem + F_KK + (tok * RW + ch) * 2), kkn);
        unpack8(*(const uint4*)(smem + F_RL + (tok * RW + ch) * 2), rr);
        ld8f(w0 + ch, cw0); ld8f(w0 + RW + ch, cw1); ld8f(a0 + ch, ca0); ld8f(a0 + RW + ch, ca1); ld8f(ka_ + ch, cka); ld8f(rk_ + ch, crk);
        float d0[8], d1[8], k0[8], k1[8], b0[8], b1[8];
        float bon = 0.f;
        UFOR(x, 8) {
          d0[x] = 0.6065306597126334f * sigmoidf_(cw0[x] + xw0[x]);
          d1[x] = 0.6065306597126334f * sigmoidf_(cw1[x] + xw1[x]);
          const float av0 = sigmoidf_(ca0[x] + ya0[x]), av1 = sigmoidf_(ca1[x] + ya1[x]);
          k0[x] = kv[x] * (1.f + (av0 - 1.f) * cka[x]); k1[x] = kv[x] * (1.f + (av1 - 1.f) * cka[x]);
          b0[x] = kkn[x] * av0; b1[x] = kkn[x] * av1;
          bon += rr[x] * 0.5f * (k0[x] + k1[x]) * crk[x];
        }
        const size_t go = (size_t)r * RW + ch;
        *(uint4*)(FA(3) + go) = packh8(d0); *(uint4*)(FA(4) + go) = packh8(d1);
        *(uint4*)(FA(5) + go) = pack8(k0); *(uint4*)(FA(6) + go) = pack8(k1);
        *(uint4*)(FA(7) + go) = pack8(b0); *(uint4*)(FA(8) + go) = pack8(b1);
        *(uint4*)(FA(9) + go) = pack8(gg);
        bon += dppf<0xB1>(bon); bon += dppf<0x4E>(bon);
        if (g4 == 0) atomicAdd(&sbl[tok * 12 + hd], bon);
      }
      asm volatile("s_waitcnt lgkmcnt(0)" ::: "memory");
    }
    LDS_BARRIER();
    if (tid_ < 192) sb[(size_t)(R0 + tid_ / 12) * 12 + (tid_ % 12)] = sbl[tid_];
  }
}

#define S_FEAT 0
#define S_V 81920
#define S_Y 86016
__device__ __forceinline__ int scan_row(int c, int s, int b, int dir) {
  if (c < 8) { const int ps = c * 32 + s; return ML + b * CTX + (dir ? (CTX - 1 - ps) : ps); }
  const int ps = (c - 8) * 32 + s; return b * TL + (dir ? (TL - 1 - ps) : ps);
}
__device__ __forceinline__ void phase_scan(KP p) {
  const int tid_ = tidx(); const int bid_ = bidx(); (void)bid_;
  p = kp_launder(p);
  const int tid = tid_, lane = tid & 63, w = tid >> 6;
  u16* Y = (u16*)(p->ws + OFF_Y);
  float* feat = (float*)(smem + S_FEAT);
  float* vbuf = (float*)(smem + S_V);
  float* ybuf = (float*)(smem + S_Y);
  const int NCH = 8 + TL / 32;
  for (int it = bid_; it < 192; it += gridDim.x) {
    const int rg = it & 3, dir = (it >> 2) & 1, bh = it >> 3, b = bh / 12, h = bh % 12;
    const u16* fr_ = FA(0); const u16* fkk = FA(1); const u16* fv = FA(2);
    const u16* fdw = FA(3 + dir); const u16* fkey = FA(5 + dir); const u16* fb = FA(7 + dir);
    u16* Yd = Y + (size_t)dir * MT * RW;
    f2 S01 = {0.f, 0.f}, S23 = {0.f, 0.f};
    const int rl = lane >> 4, cs = lane & 15;
    const int rowl = (w & 3) * 4 + rl;
    __syncthreads();
    const int pth = tid_ - 256, ppair = (pth >> 7) & 1, pt = pth & 127;
    uint4 rq[2][6];
    UFOR(x, 6) { rq[0][x] = make_uint4(0, 0, 0, 0); rq[1][x] = rq[0][x]; }
    if (w >= 4) {
      UFOR(e, 2) {
        const int q = pt + 128 * e, st = q >> 3, g8 = q & 7;
        const size_t o = (size_t)scan_row(ppair, st, b, dir) * RW + h * 64 + g8 * 8;
        rq[e][0] = *(const uint4*)(fr_ + o); rq[e][1] = *(const uint4*)(fdw + o); rq[e][2] = *(const uint4*)(fkey + o);
        rq[e][3] = *(const uint4*)(fkk + o); rq[e][4] = *(const uint4*)(fb + o); rq[e][5] = *(const uint4*)(fv + o);
      }
    }
    for (int c = -1; c < NCH; ++c) {
      if (w >= 4) {
        if (((c + 1) & 1) == ppair) {
          if (c + 1 < NCH) {
            const int buf = (c + 1) & 1;
            UFOR(e, 2) {
              const int q = pt + 128 * e, st = q >> 3, g8 = q & 7;
              float f[8];
              float* fd = feat + ((buf * 32 + st) * 5) * 64 + g8 * 8;
              unpack8(rq[e][0], f); *(float4*)(fd) = make_float4(f[0], f[1], f[2], f[3]); *(float4*)(fd + 4) = make_float4(f[4], f[5], f[6], f[7]);
              { const uint4 u = rq[e][1];
                f[0] = h2f((u16)(u.x & 0xffff)); f[1] = h2f((u16)(u.x >> 16)); f[2] = h2f((u16)(u.y & 0xffff)); f[3] = h2f((u16)(u.y >> 16));
                f[4] = h2f((u16)(u.z & 0xffff)); f[5] = h2f((u16)(u.z >> 16)); f[6] = h2f((u16)(u.w & 0xffff)); f[7] = h2f((u16)(u.w >> 16));
                UFOR(x, 8) f[x] = __expf(-f[x]);
                *(float4*)(fd + 64) = make_float4(f[0], f[1], f[2], f[3]); *(float4*)(fd + 68) = make_float4(f[4], f[5], f[6], f[7]); }
              unpack8(rq[e][2], f); *(float4*)(fd + 128) = make_float4(f[0], f[1], f[2], f[3]); *(float4*)(fd + 132) = make_float4(f[4], f[5], f[6], f[7]);
              unpack8(rq[e][3], f); *(float4*)(fd + 192) = make_float4(-f[0], -f[1], -f[2], -f[3]); *(float4*)(fd + 196) = make_float4(-f[4], -f[5], -f[6], -f[7]);
              unpack8(rq[e][4], f); *(float4*)(fd + 256) = make_float4(f[0], f[1], f[2], f[3]); *(float4*)(fd + 260) = make_float4(f[4], f[5], f[6], f[7]);
              if ((g8 >> 1) == rg) {
                unpack8(rq[e][5], f);
                float* vd = vbuf + (buf * 16 + (g8 & 1) * 8) * 32 + st;
                UFOR(x, 8) vd[x * 32] = f[x];
              }
            }
          }
          if (c + 3 < NCH) {
            UFOR(e, 2) {
              const int q = pt + 128 * e, st = q >> 3, g8 = q & 7;
              const size_t o = (size_t)scan_row(c + 3, st, b, dir) * RW + h * 64 + g8 * 8;
              rq[e][0] = *(const uint4*)(fr_ + o); rq[e][1] = *(const uint4*)(fdw + o); rq[e][2] = *(const uint4*)(fkey + o);
              rq[e][3] = *(const uint4*)(fkk + o); rq[e][4] = *(const uint4*)(fb + o); rq[e][5] = *(const uint4*)(fv + o);
            }
          }
        } else if (c >= 1) {
          const int buf = (c - 1) & 1;
          UFOR(e, 4) {
            const int q = pt + 128 * e, st = q >> 4, rw = q & 15;
            Yd[(size_t)scan_row(c - 1, st, b, dir) * RW + h * 64 + rg * 16 + rw] = f2bf(ybuf[(buf * 32 + st) * 16 + rw]);
          }
        }
      } else if (c >= 0) {
        const int buf = c & 1;
        const float* fbase = feat + (buf * 32) * 320 + cs * 4;
        const float* vb4 = vbuf + (buf * 16 + rowl) * 32;
        const bool b3 = (cs & 8) != 0, b2 = (cs & 4) != 0;
        float* yb = ybuf + (buf * 32 + (b3 ? 2 : 0) + (b2 ? 1 : 0)) * 16 + rowl;
        float4 Ar, Aw, Ak, An, Ab, Br, Bw, Bk, Bn, Bb, Cr, Cw, Ck, Cn, Cb, Dr, Dw, Dk, Dn, Db;
        float4 vcur = *(const float4*)vb4, vnext;
        float q0 = 0.f, q1 = 0.f, q2 = 0.f, q3 = 0.f, p0 = 0.f, p1 = 0.f, p2 = 0.f, p3 = 0.f;
#define SLD(R, st_) { const float* fd = fbase + (st_) * 320; R##r = *(const float4*)fd; R##w = *(const float4*)(fd + 64); R##k = *(const float4*)(fd + 128); \
                      R##n = *(const float4*)(fd + 192); R##b = *(const float4*)(fd + 256); }
#define SCOMP(R, VV, QQ) { \
          f2 p = S01 * (f2){R##n.x, R##n.y}; p = S23 * (f2){R##n.z, R##n.w} + p; \
          float sa = red16(p.x + p.y); \
          f2 u01 = (f2){R##k.x, R##k.y} * (VV); u01 = S01 * (f2){R##w.x, R##w.y} + u01; \
          f2 u23 = (f2){R##k.z, R##k.w} * (VV); u23 = S23 * (f2){R##w.z, R##w.w} + u23; \
          S01 = (f2){R##b.x, R##b.y} * sa + u01; S23 = (f2){R##b.z, R##b.w} * sa + u23; \
          f2 q = S01 * (f2){R##r.x, R##r.y}; q = S23 * (f2){R##r.z, R##r.w} + q; \
          QQ = q.x + q.y; }
#define YRED4(dst) { \
          float a0 = b3 ? p2 : p0, a1 = b3 ? p3 : p1; const float s0 = b3 ? p0 : p2, s1 = b3 ? p1 : p3; \
          a0 += dppf<0x128>(s0); a1 += dppf<0x128>(s1); \
          float cc = b2 ? a1 : a0; const float dd = b2 ? a0 : a1; \
          cc += dppf<0x141>(dd); cc += dppf<0xB1>(cc); cc += dppf<0x4E>(cc); dst = cc; }
        SLD(A, 0); SLD(B, 1);
        for (int g = 0; g < 8; ++g) {
          const int st = g * 4;
          SLD(C, st + 2); vnext = *(const float4*)(vb4 + st + 4);
          __builtin_amdgcn_sched_barrier(0);
          if (g > 0) { float yv; YRED4(yv); yb[(st - 4) * 16] = yv; }
          SCOMP(A, vcur.x, q0);
          SLD(D, st + 3);
          __builtin_amdgcn_sched_barrier(0);
          SCOMP(B, vcur.y, q1);
          SLD(A, st + 4);
          __builtin_amdgcn_sched_barrier(0);
          SCOMP(C, vcur.z, q2);
          SLD(B, st + 5);
          __builtin_amdgcn_sched_barrier(0);
          SCOMP(D, vcur.w, q3);
          vcur = vnext; p0 = q0; p1 = q1; p2 = q2; p3 = q3;
        }
        { float yv; YRED4(yv); yb[28 * 16] = yv; }
#undef SLD
#undef SCOMP
#undef YRED4
      }
      asm volatile("s_waitcnt lgkmcnt(0)" ::: "memory");
      __builtin_amdgcn_s_barrier();
      asm volatile("" ::: "memory");
    }
    if (w >= 4) {
      const int buf = (NCH - 1) & 1;
      for (int q = pth; q < 512; q += 256) {
        const int st = q >> 4, rw = q & 15;
        Yd[(size_t)scan_row(NCH - 1, st, b, dir) * RW + h * 64 + rg * 16 + rw] = f2bf(ybuf[(buf * 32 + st) * 16 + rw]);
      }
    }
    __syncthreads();
  }
}

__device__ __forceinline__ void phase_rwkv_out(KP p, int l, int nrows) {
  const int tid_ = tidx(); const int bid_ = bidx(); (void)bid_;
  p = kp_launder(p);
  const u16* Y = (const u16*)(p->ws + OFF_Y);
  const float* sb = (const float*)(p->ws + OFF_SB);
  u16* mix = (u16*)(p->ws + OFF_A);
  const float* lg = p->in[18] + (size_t)l * RW; const float* lb = p->in[19] + (size_t)l * RW;
  const int lane = tid_ & 63, w = tid_ >> 6;
  for (int r = bid_ * 8 + w; r < nrows; r += gridDim.x * 8) {
    uint2 yf[3], yb[3], vv[3], gg[3]; float sbv[3];
    UFOR(j, 3) {
      const size_t o = (size_t)r * RW + j * 256 + lane * 4;
      yf[j] = *(const uint2*)(Y + o); yb[j] = *(const uint2*)(Y + (size_t)MT * RW + o);
      vv[j] = *(const uint2*)(FA(2) + o); gg[j] = *(const uint2*)(FA(9) + o);
      sbv[j] = sb[(size_t)r * 12 + j * 4 + (lane >> 4)];
    }
    UFOR(j, 3) {
      const int c = j * 256 + lane * 4;
      float y[4] = {lo2f(yf[j].x) + lo2f(yb[j].x), hi2f(yf[j].x) + hi2f(yb[j].x), lo2f(yf[j].y) + lo2f(yb[j].y), hi2f(yf[j].y) + hi2f(yb[j].y)};
      const float mu = red16((y[0] + y[1]) + (y[2] + y[3])) * (1.f / 64.f);
      UFOR(x, 4) y[x] -= mu;
      const float var = red16((y[0] * y[0] + y[1] * y[1]) + (y[2] * y[2] + y[3] * y[3])) * (1.f / 64.f);
      const float rstd = rsqrtf(var + 64e-5f);
      const float4 lgv = *(const float4*)(lg + c), lbv = *(const float4*)(lb + c);
      const float v[4] = {lo2f(vv[j].x), hi2f(vv[j].x), lo2f(vv[j].y), hi2f(vv[j].y)};
      const float g[4] = {lo2f(gg[j].x), hi2f(gg[j].x), lo2f(gg[j].y), hi2f(gg[j].y)};
      const float o0 = (y[0] * rstd * lgv.x + lbv.x + sbv[j] * v[0]) * g[0];
      const float o1 = (y[1] * rstd * lgv.y + lbv.y + sbv[j] * v[1]) * g[1];
      const float o2 = (y[2] * rstd * lgv.z + lbv.z + sbv[j] * v[2]) * g[2];
      const float o3 = (y[3] * rstd * lgv.w + lbv.w + sbv[j] * v[3]) * g[3];
      uint2 pk; pk.x = pk2(o0, o1); pk.y = pk2(o2, o3);
      *(uint2*)(mix + (size_t)r * DM + c) = pk;
    }
  }
}


#define XB_TMO      128
#define XB_XCNT(j)  (256  + 64 * (j))
#define XB_XSUB(j)  (1280 + 64 * (j))
#define XB_XGEN(j)  (2304 + 64 * (j))
#define XB_TOP      3328
#define XB_TOPGEN   3392
#define XCD_BAR_WORDS 3456
#define XB_SPIN_CAP (1u << 18)
#define LAS __attribute__((address_space(3)))
__device__ __forceinline__ unsigned xb_ld(unsigned* p)              { return __hip_atomic_load(p, __ATOMIC_RELAXED, __HIP_MEMORY_SCOPE_AGENT); }
__device__ __forceinline__ unsigned xb_add(unsigned* p, unsigned v) { return __hip_atomic_fetch_add(p, v, __ATOMIC_RELAXED, __HIP_MEMORY_SCOPE_AGENT); }
__device__ __forceinline__ unsigned xb_xcc_id() { return (unsigned)__builtin_amdgcn_s_getreg((3 << 11) | 20) & 0xFu; }
#define XB_SPIN(cond, bar) do { unsigned _sp = 0; while (cond) { __builtin_amdgcn_s_sleep(1); \
    if ((++_sp & 255u) == 0u) { if (xb_ld(&(bar)[XB_TMO])) break; if (_sp > XB_SPIN_CAP) { atomicAdd(&(bar)[XB_TMO], 1u); break; } } } } while (0)
struct XcdBarrier { unsigned* bar; unsigned x; volatile LAS unsigned* st; };
__device__ __forceinline__ XcdBarrier xcd_barrier_post(unsigned* bar, volatile LAS unsigned* st) {
    XcdBarrier b; b.bar = bar; b.x = xb_xcc_id(); b.st = st;
    if (threadIdx.x == 0) (void)xb_add(&bar[XB_XCNT(b.x)], 1u);
    return b;
}
__device__ __forceinline__ void xcd_barrier_complete(unsigned* bar, unsigned x, unsigned& nloc, unsigned& nx) {
    const unsigned G = gridDim.x * gridDim.y * gridDim.z;
    unsigned sum, cnt, mine, sp = 0u;
    for (;;) {
        sum = 0u; cnt = 0u; mine = 0u;
#pragma unroll
        for (unsigned j = 0; j < 16; ++j) { const unsigned c = xb_ld(&bar[XB_XCNT(j)]); sum += c; cnt += (c > 0u) ? 1u : 0u; mine = (j == x) ? c : mine; }
        if (sum == G) break;
        __builtin_amdgcn_s_sleep(1);
        if ((++sp & 255u) == 0u) { if (xb_ld(&bar[XB_TMO])) break; if (sp > XB_SPIN_CAP) { atomicAdd(&bar[XB_TMO], 1u); break; } }
    }
    nloc = mine > 0u ? mine : 1u; nx = cnt > 0u ? cnt : 1u;
}
__device__ __forceinline__ void xcd_barrier(const XcdBarrier& b) {
    asm volatile("s_waitcnt vmcnt(0)" ::: "memory");
    __syncthreads();
    if (threadIdx.x == 0) {
        unsigned* bar = b.bar;
        __builtin_amdgcn_s_waitcnt(0);
        unsigned nloc = b.st[0], nx = b.st[1];
        if (nloc == 0u) { xcd_barrier_complete(bar, b.x, nloc, nx); b.st[0] = nloc; b.st[1] = nx; }
        const unsigned old = xb_add(&bar[XB_XSUB(b.x)], 1u);
        const unsigned gen = old / nloc;
        if (old + 1u == (gen + 1u) * nloc) {
            __builtin_amdgcn_fence(__ATOMIC_RELEASE, "agent");
            asm volatile("s_waitcnt vmcnt(0)" ::: "memory");
            const unsigned og = xb_add(&bar[XB_TOP], 1u);
            const unsigned tg = og / nx;
            if (og + 1u == (tg + 1u) * nx) xb_add(&bar[XB_TOPGEN], 1u);
            else XB_SPIN(xb_ld(&bar[XB_TOPGEN]) == tg, bar);
            __builtin_amdgcn_fence(__ATOMIC_ACQUIRE, "agent");
            xb_add(&bar[XB_XGEN(b.x)], 1u);
            asm volatile("s_waitcnt vmcnt(0)" ::: "memory");
        } else {
            XB_SPIN(xb_ld(&bar[XB_XGEN(b.x)]) == gen, bar);
            __builtin_amdgcn_fence(__ATOMIC_ACQUIRE, "agent");
            asm volatile("s_waitcnt vmcnt(0)" ::: "memory");
        }
    }
    __syncthreads();
}

#ifndef REP_SCAN
#define REP_SCAN 1
#endif
#ifndef REP_FEAT
#define REP_FEAT 1
#endif
#ifndef REP_R3
#define REP_R3 1
#endif
#ifndef REP_ROUT
#define REP_ROUT 1
#endif
#ifndef REP_GIN
#define REP_GIN 1
#endif
__global__ void __launch_bounds__(NTHREADS) fwd_kernel(Params pk_unused, int ph_lo, int ph_hi, int use_sync) {
  KP p = (KP)__builtin_amdgcn_kernarg_segment_ptr();
  cg::grid_group grid = cg::this_grid();
  volatile LAS unsigned* xst = (volatile LAS unsigned*)(smem + LDS_BYTES - 16);
  if (threadIdx.x == 0) { xst[0] = 0u; xst[1] = 0u; xst[2] = 0u; xst[3] = 0u; }
  __syncthreads();
  XcdBarrier xb = xcd_barrier_post((unsigned*)(p->ws + OFF_BAR), xst);
  if (use_sync == 0x7fffffff) grid.sync();
  int ph = 0;
#define PHASE_BEGIN if (ph >= ph_lo && ph < ph_hi) {
#define PHASE_END } if (use_sync && ph >= ph_lo && ph + 1 < ph_hi) { xcd_barrier(xb); } ++ph;
  const float* mods = (const float*)(p->ws + OFF_MODS);
  PHASE_BEGIN
    phase_mods(p);
    __syncthreads();
    convert_win(p, 0, 0, gridDim.x);
    phase_misc0(p);
  PHASE_END
  for (int l = 0; l < 2; ++l) {
    const float* modl = mods + (size_t)l * 3 * 12288;
    PHASE_BEGIN
      phase_norm(p, l, 0, MT);
    PHASE_END
    PHASE_BEGIN
      EpiArgs e{}; e.zrw = (u16*)(p->ws + OFF_ZRW); e.zcr = (u16*)(p->ws + OFF_ZCR);
      for (int rep = 0; rep < REP_GIN; ++rep) gemm_phase<EPI_Z, DM>((const u16*)(p->ws + OFF_A), (const u16*)(p->ws + OFF_WIN), MT / 256, INC / 256, e);
    PHASE_END
    PHASE_BEGIN
      phase_ret_summaries(p);
      __syncthreads();
      phase_convmix(p, l, l == 1 ? ML : MT);
    PHASE_END
    PHASE_BEGIN
      for (int rep = 0; rep < REP_R3; ++rep) phase_ret_out(p, l, l == 0);
    PHASE_END
    PHASE_BEGIN
      for (int rep = 0; rep < REP_FEAT; ++rep) phase_features(p, l);
    PHASE_END
    PHASE_BEGIN
      phase_scan(p);
      {
        const int cf = gridDim.x > 192 ? 192 : 0, cs_ = gridDim.x > 192 ? (int)gridDim.x - 192 : (int)gridDim.x;
        __syncthreads();
        convert_ffn(p, l, cf, cs_);
        if (l == 0) { convert_wout(p, 0, cf, cs_); convert_win(p, 1, cf, cs_); }
      }
    PHASE_END
    PHASE_BEGIN
      for (int rep = 0; rep < REP_ROUT; ++rep) phase_rwkv_out(p, l, l == 1 ? ML : MT);
    PHASE_END
    PHASE_BEGIN
      EpiArgs e{};
      e.srcL = (l == 0) ? p->in[0] : p->out; e.srcC = (l == 0) ? p->in[2] : (const float*)(p->ws + OFF_XC);
      e.dstL = p->out; e.dstC = (float*)(p->ws + OFF_XC); e.gate = modl + 2 * DM;
      gemm_phase<EPI_RES, DM>((const u16*)(p->ws + OFF_A), (const u16*)(p->ws + OFF_WOUT), l == 1 ? 128 : 130, DM / 256, e);
    PHASE_END
    PHASE_BEGIN
      phase_norm(p, l, 1, l == 1 ? ML : MT);
      if (l == 0) { __syncthreads(); convert_wout(p, 1, 0, gridDim.x); }
    PHASE_END
    PHASE_BEGIN
      EpiArgs e{}; e.h2 = (u16*)(p->ws + OFF_H2); e.cw = p->in[24] + (size_t)l * 2 * DFF * 3;
      gemm_phase<EPI_UPG, DM>((const u16*)(p->ws + OFF_A), (const u16*)(p->ws + OFF_WUP), l == 1 ? 130 : 132, DFF / 128, e);
    PHASE_END
    PHASE_BEGIN
      EpiArgs e{};
      e.srcL = p->out; e.srcC = (const float*)(p->ws + OFF_XC); e.dstL = p->out; e.dstC = (float*)(p->ws + OFF_XC); e.gate = modl + 5 * DM;
      gemm_phase<EPI_RES, DFF>((const u16*)(p->ws + OFF_H2), (const u16*)(p->ws + OFF_WDN), 128, DM / 256, e);
      if (l == 0) gemm_ctx_splitk_down((const u16*)(p->ws + OFF_H2), (const u16*)(p->ws + OFF_WDN), (float*)(p->ws + OFF_P2), e);
    PHASE_END
  }
  PHASE_BEGIN
    phase_final(p);
  PHASE_END
}

#define NPHASES 24

extern "C" void kernel_launch(void* const* d_in, const int* in_sizes, int n_in, void* d_out, int out_size, void* d_ws, size_t ws_size,
                              hipStream_t stream) {
  static int grid = 0;
  if (grid == 0) {
    int dev = 0, cus = 0, per_cu = 0;
    hipGetDevice(&dev);
    hipDeviceGetAttribute(&cus, hipDeviceAttributeMultiprocessorCount, dev);
    hipFuncSetAttribute((const void*)fwd_kernel, hipFuncAttributeMaxDynamicSharedMemorySize, LDS_BYTES);
    hipOccupancyMaxActiveBlocksPerMultiprocessor(&per_cu, (const void*)fwd_kernel, NTHREADS, LDS_BYTES);
    (void)hipGetLastError();
    if (per_cu < 1) per_cu = 1;
    grid = cus;
    if (ws_size < 952 * MIB) fprintf(stderr, "kernel_launch: workspace too small: %zu\n", ws_size);
  }
  if (hipMemsetAsync((char*)d_ws + OFF_BAR, 0, 16384, stream) != hipSuccess) fprintf(stderr, "kernel_launch: memset of barrier words failed\n");
  Params p{};
  UFOR(i, 27) p.in[i] = (const float*)d_in[i];
  p.out = (float*)d_out;
  p.ws = (char*)d_ws;
  int lo = 0, hi = NPHASES, us = 1;
  void* args[] = {&p, &lo, &hi, &us};
  hipError_t e = hipLaunchCooperativeKernel((const void*)fwd_kernel, dim3(grid), dim3(NTHREADS), args, LDS_BYTES, stream);
  if (e != hipSuccess) fprintf(stderr, "cooperative launch failed: %s (grid %d)\n", hipGetErrorString(e), grid);
}
```

```cpp
#include <hip/hip_runtime.h>
#include <hip/hip_cooperative_groups.h>
#include <cstdio>
#include <cstdint>
namespace cg = cooperative_groups;

typedef unsigned short u16;
typedef short bf16x8 __attribute__((ext_vector_type(8)));
typedef float f32x4 __attribute__((ext_vector_type(4)));
typedef float f2 __attribute__((ext_vector_type(2)));
#define UFOR(v, n) _Pragma("unroll") for (int v = 0; v < (n); ++v)

#define DM 2048
#define TL 16384
#define CTX 256
#define ML 32768
#define MT 33280
#define RW 768
#define RWC 2560
#define CRC 4608
#define INC 7168
#define DFF 5632
#define NTHREADS 512
#define LDS_BYTES 147456

#define MIB ((size_t)1 << 20)
#define OFF_MODS ((size_t)0)
#define OFF_BAR ((size_t)524288)
#define OFF_ROPE (1 * MIB)
#define OFF_XC (9 * MIB)
#define OFF_SB (13 * MIB)
#define OFF_LORA (15 * MIB)
#define OFF_KV (17 * MIB)
#define OFF_WIN (67 * MIB)
#define OFF_WOUT (95 * MIB)
#define OFF_WUP (103 * MIB)
#define OFF_WDN (147 * MIB)
#define OFF_A (170 * MIB)
#define OFF_ZRW (301 * MIB)
#define OFF_ZCR (464 * MIB)
#define OFF_SCR (757 * MIB)
#define FEAT_SZ ((size_t)MT * RW * 2)
#define OFF_FEAT OFF_ZCR
#define OFF_Y OFF_ZRW
#define OFF_H2 OFF_ZCR
#define LORA_L 294912

struct Params {
  const float* in[27];
  float* out;
  char* ws;
};

typedef const __attribute__((address_space(4))) Params* KP;
__device__ __forceinline__ KP kp_launder(KP k) { unsigned z; asm volatile("s_mov_b32 %0, 0" : "=s"(z)); return (KP)((const __attribute__((address_space(4))) char*)__builtin_amdgcn_kernarg_segment_ptr() + z); }

extern __shared__ __attribute__((aligned(16))) char smem[];
#define LDS_BARRIER() do { asm volatile("s_waitcnt lgkmcnt(0)" ::: "memory"); __builtin_amdgcn_s_barrier(); asm volatile("" ::: "memory"); } while (0)

__device__ __forceinline__ u16 f2bf(float f) {
  unsigned u = __float_as_uint(f);
  u += 0x7fffu + ((u >> 16) & 1u);
  return (u16)(u >> 16);
}
__device__ __forceinline__ float bf2f(u16 h) { return __uint_as_float(((unsigned)h) << 16); }
__device__ __forceinline__ unsigned pk2(float a, float b) { return (unsigned)f2bf(a) | ((unsigned)f2bf(b) << 16); }
__device__ __forceinline__ float lo2f(unsigned u) { return __uint_as_float(u << 16); }
__device__ __forceinline__ float hi2f(unsigned u) { return __uint_as_float(u & 0xffff0000u); }
__device__ __forceinline__ u16 f2h(float f) { _Float16 h = (_Float16)f; return __builtin_bit_cast(u16, h); }
__device__ __forceinline__ float h2f(u16 u) { _Float16 h = __builtin_bit_cast(_Float16, u); return (float)h; }
template <int CTRL>
__device__ __forceinline__ float dppf(float v) {
  return __int_as_float(__builtin_amdgcn_mov_dpp(__float_as_int(v), CTRL, 0xf, 0xf, true));
}
__device__ __forceinline__ float red16(float v) {
  v += dppf<0xB1>(v);
  v += dppf<0x4E>(v);
  v += dppf<0x141>(v);
  v += dppf<0x140>(v);
  return v;
}
__device__ __forceinline__ float wave_sum(float v) {
  v = red16(v);
  const int iv = __float_as_int(v);
  return (__int_as_float(__builtin_amdgcn_readlane(iv, 0)) + __int_as_float(__builtin_amdgcn_readlane(iv, 16))) +
         (__int_as_float(__builtin_amdgcn_readlane(iv, 32)) + __int_as_float(__builtin_amdgcn_readlane(iv, 48)));
}
__device__ __forceinline__ int tidx() { int t = threadIdx.x; asm volatile("" : "+v"(t)); return t; }
__device__ __forceinline__ int bidx() { int t = blockIdx.x; asm volatile("" : "+s"(t)); return t; }
__device__ __forceinline__ float sigmoidf_(float x) { return 1.f / (1.f + __expf(-x)); }
__device__ __forceinline__ float siluf_(float x) { return x / (1.f + __expf(-x)); }
__device__ __forceinline__ void seqinfo(int r, int& s0, int& len, int& mrow) {
  if (r < ML) { int b = r >> 14; s0 = b << 14; len = TL; mrow = b; }
  else { int b = (r - ML) >> 8; s0 = ML + (b << 8); len = CTX; mrow = 2; }
}
__device__ __forceinline__ void unpack8(uint4 u, float* f) {
  f[0] = lo2f(u.x); f[1] = hi2f(u.x); f[2] = lo2f(u.y); f[3] = hi2f(u.y);
  f[4] = lo2f(u.z); f[5] = hi2f(u.z); f[6] = lo2f(u.w); f[7] = hi2f(u.w);
}
__device__ __forceinline__ uint4 pack8(const float* f) {
  uint4 u; u.x = pk2(f[0], f[1]); u.y = pk2(f[2], f[3]); u.z = pk2(f[4], f[5]); u.w = pk2(f[6], f[7]); return u;
}

__device__ __forceinline__ void transpose_convert(const float* __restrict__ W, int K, int N, u16* __restrict__ WT, int mode, int bfirst, int bstride) {
  const int tid_ = tidx(); const int bid_ = bidx(); (void)bid_;
  float* tile = (float*)smem;
  const int tk = K / 64, tn = N / 128, nit = tk * tn;
  const int lr = tid_ >> 5, lc = (tid_ & 31) * 4;
  float4 v[4];
  int it = bid_ - bfirst;
  if (it < 0) return;
  if (it < nit) {
    const int k0 = (it / tn) * 64, n0 = (it % tn) * 128;
    UFOR(i, 4) v[i] = *(const float4*)(W + (size_t)(k0 + lr + 16 * i) * N + n0 + lc);
  }
  while (it < nit) {
    const int k0 = (it / tn) * 64, n0 = (it % tn) * 128;
    UFOR(i, 4) { float* t = tile + (lr + 16 * i) * 129 + lc; t[0] = v[i].x; t[1] = v[i].y; t[2] = v[i].z; t[3] = v[i].w; }
    LDS_BARRIER();
    const int nx = it + bstride;
    if (nx < nit) {
      const int k1 = (nx / tn) * 64, n1 = (nx % tn) * 128;
      UFOR(i, 4) v[i] = *(const float4*)(W + (size_t)(k1 + lr + 16 * i) * N + n1 + lc);
    }
    const int n = tid_ >> 2, kc = tid_ & 3;
    float f[16];
    UFOR(i, 16) f[i] = tile[(kc * 16 + i) * 129 + n];
    const int ng = n0 + n;
    int dn = ng;
    if (mode == 1) dn = (ng < DFF) ? ((ng >> 7) * 256 + (ng & 127)) : ((((ng - DFF) >> 7) * 256) + 128 + ((ng - DFF) & 127));
    dn = (dn & ~31) | ((((dn >> 2) & 1) << 4) | (((dn >> 3) & 3) << 2) | (dn & 3));
    u16* d = WT + (size_t)dn * K + k0 + kc * 16;
    *(uint4*)d = pack8(f); *(uint4*)(d + 8) = pack8(f + 8);
    LDS_BARRIER();
    it = nx;
  }
}

__device__ __forceinline__ void phase_mods(KP p) {
  const int tid_ = tidx(); const int bid_ = bidx(); (void)bid_;
  p = kp_launder(p);
  float* sc = (float*)smem;
  float* red = sc + 3 * DM;
  float* mods = (float*)(p->ws + OFF_MODS);
  const int tid = tid_;
  for (int i = tid; i < 3 * DM; i += NTHREADS) {
    const float v = (i < 2 * DM) ? p->in[1][i] : p->in[3][i - 2 * DM];
    sc[i] = siluf_(v);
  }
  __syncthreads();
  for (int it = bid_; it < 256; it += gridDim.x) {
    const int l = it >> 7, col0 = (it & 127) * 96;
    const float* W = p->in[4] + (size_t)l * DM * 12288;
    const int kg = tid / 24, c4 = tid % 24;
    float acc[3][4] = {};
    if (kg < 21) {
#pragma unroll 8
      for (int k = kg; k < DM; k += 21) {
        const float4 w = *(const float4*)(W + (size_t)k * 12288 + col0 + c4 * 4);
        UFOR(m, 3) {
          const float s = sc[m * DM + k];
          acc[m][0] += s * w.x; acc[m][1] += s * w.y; acc[m][2] += s * w.z; acc[m][3] += s * w.w;
        }
      }
      UFOR(m, 3)
        UFOR(q, 4) red[(kg * 3 + m) * 96 + c4 * 4 + q] = acc[m][q];
    }
    __syncthreads();
    if (tid < 288) {
      const int m = tid / 96, c = tid % 96;
      float s = 0.f;
      UFOR(g, 21) s += red[(g * 3 + m) * 96 + c];
      mods[(size_t)(l * 3 + m) * 12288 + col0 + c] = s + p->in[5][(size_t)l * 12288 + col0 + c];
    }
    __syncthreads();
  }
}

__device__ __forceinline__ void phase_misc0(KP p) {
  const int tid_ = tidx(); const int bid_ = bidx(); (void)bid_;
  p = kp_launder(p);
  const int gtid = bid_ * NTHREADS + tid_, gn = gridDim.x * NTHREADS;
  float* rc = (float*)(p->ws + OFF_ROPE);
  float* rs = rc + TL * 64;
  for (int i = gtid; i < TL * 64; i += gn) {
    const int t = i >> 6, j = i & 63;
    const float fr = 1.0f / powf(10000.0f, (float)(j & 31) / 32.0f);
    const float pos = (j < 32) ? (float)(t >> 6) : (float)(t & 63);
    const float ang = pos * fr;
    rc[i] = cosf(ang); rs[i] = sinf(ang);
  }
  u16* lora = (u16*)(p->ws + OFF_LORA);
  for (int i = gtid; i < 2 * LORA_L; i += gn) {
    const int l = i / LORA_L; int r = i % LORA_L;
    float v;
    if (r < 98304) { const int d = r / 49152, q = r % 49152, ch = q >> 6, k = q & 63; v = p->in[11][((size_t)(l * 2 + d) * 64 + k) * RW + ch]; }
    else if (r < 196608) { r -= 98304; const int d = r / 49152, q = r % 49152, ch = q >> 6, k = q & 63; v = p->in[13][((size_t)(l * 2 + d) * 64 + k) * RW + ch]; }
    else { r -= 196608; const int ch = r >> 7, k = r & 127; v = p->in[14][((size_t)l * 128 + k) * RW + ch]; }
    lora[i] = f2bf(v);
  }
}

__device__ __forceinline__ void convert_win(KP p, int l, int bf, int bs) { transpose_convert(p->in[8] + (size_t)l * DM * INC, DM, INC, (u16*)(p->ws + OFF_WIN), 0, bf, bs); }
__device__ __forceinline__ void convert_wout(KP p, int l, int bf, int bs) { transpose_convert(p->in[22] + (size_t)l * DM * DM, DM, DM, (u16*)(p->ws + OFF_WOUT), 0, bf, bs); }
__device__ __forceinline__ void convert_ffn(KP p, int l, int bf, int bs) {
  transpose_convert(p->in[23] + (size_t)l * DM * 2 * DFF, DM, 2 * DFF, (u16*)(p->ws + OFF_WUP), 1, bf, bs);
  transpose_convert(p->in[25] + (size_t)l * DFF * DM, DFF, DM, (u16*)(p->ws + OFF_WDN), 0, bf, bs);
}

__device__ __forceinline__ const float* norm_src(KP p, int l, int which, int r) {
  if (r < ML) return ((l == 0 && which == 0) ? p->in[0] : p->out) + (size_t)r * DM;
  return ((l == 0 && which == 0) ? p->in[2] : (const float*)(p->ws + OFF_XC)) + (size_t)(r - ML) * DM;
}
__device__ __forceinline__ void phase_norm(KP p, int l, int which, int nrows) {
  const int tid_ = tidx(); const int bid_ = bidx(); (void)bid_;
  p = kp_launder(p);
  const float* mods = (const float*)(p->ws + OFF_MODS) + (size_t)l * 3 * 12288;
  const float* g = p->in[which ? 7 : 6] + (size_t)l * DM;
  u16* A = (u16*)(p->ws + OFF_A);
  const int lane = tid_ & 63, wv = tid_ >> 6;
  const int sh = which ? 3 : 0, scl = which ? 4 : 1;
  const int stride = gridDim.x * 8;
  float4 va[8], vb[8];
#define NORM_LOAD(V, R_) { const float* s = norm_src(p, l, which, (R_)); UFOR(j, 8) V[j] = *(const float4*)(s + j * 256 + lane * 4); \
    if (l == 1 && which == 0 && (R_) >= ML) {     \
      const float* gt5 = (const float*)(p->ws + OFF_MODS) + (size_t)2 * 12288 + 5 * DM; \
      const float* pp = (const float*)(p->ws + (832 * MIB)) + (size_t)((R_) - ML) * DM; \
      UFOR(j, 8) { \
        const int c = j * 256 + lane * 4; \
        float4 acc4 = make_float4(0.f, 0.f, 0.f, 0.f); \
        for (int pt_ = 0; pt_ < 11; ++pt_) { const float4 q = *(const float4*)(pp + (size_t)pt_ * 512 * DM + c); acc4.x += q.x; acc4.y += q.y; acc4.z += q.z; acc4.w += q.w; } \
        const float4 g5 = *(const float4*)(gt5 + c); \
        V[j].x += g5.x * acc4.x; V[j].y += g5.y * acc4.y; V[j].z += g5.z * acc4.z; V[j].w += g5.w * acc4.w; } } }
#define NORM_BODY(V, R_) { \
    const int rr = (R_); const int mrow = rr < ML ? (rr >> 14) : 2; \
    float ss = 0.f; \
    UFOR(j, 8) ss += V[j].x * V[j].x + V[j].y * V[j].y + V[j].z * V[j].z + V[j].w * V[j].w; \
    ss = wave_sum(ss); \
    const float rstd = rsqrtf(ss * (1.0f / DM) + 1e-6f); \
    const float* ms = mods + (size_t)mrow * 12288; \
    UFOR(j, 8) { \
      const int c = j * 256 + lane * 4; \
      const float4 gg = *(const float4*)(g + c); \
      const float4 s1 = *(const float4*)(ms + scl * DM + c); \
      const float4 s0 = *(const float4*)(ms + sh * DM + c); \
      const float a = V[j].x * rstd * gg.x * (1.f + s1.x) + s0.x; \
      const float b = V[j].y * rstd * gg.y * (1.f + s1.y) + s0.y; \
      const float cc = V[j].z * rstd * gg.z * (1.f + s1.z) + s0.z; \
      const float d = V[j].w * rstd * gg.w * (1.f + s1.w) + s0.w; \
      uint2 o; o.x = pk2(a, b); o.y = pk2(cc, d); \
      *(uint2*)(A + (size_t)rr * DM + c) = o; } }
  int r = bid_ * 8 + wv;
  if (r < nrows) NORM_LOAD(va, r);
  for (; r < nrows; r += 2 * stride) {
    if (r + stride < nrows) NORM_LOAD(vb, r + stride);
    NORM_BODY(va, r);
    if (r + 2 * stride < nrows) NORM_LOAD(va, r + 2 * stride);
    if (r + stride < nrows) NORM_BODY(vb, r + stride);
  }
#undef NORM_LOAD
#undef NORM_BODY
}

__device__ __forceinline__ void phase_final(KP p) {
  const int tid_ = tidx(); const int bid_ = bidx(); (void)bid_;
  p = kp_launder(p);
  const float* g = p->in[26];
  const int lane = tid_ & 63, wv = tid_ >> 6;
  const int stride = gridDim.x * 8;
  float4 va[8], vb[8];
#define FIN_LOAD(V, R_) { const float* s = p->out + (size_t)(R_) * DM; UFOR(j, 8) V[j] = *(const float4*)(s + j * 256 + lane * 4); }
#define FIN_BODY(V, R_) { \
    float* src = p->out + (size_t)(R_) * DM; \
    float ss = 0.f; \
    UFOR(j, 8) ss += V[j].x * V[j].x + V[j].y * V[j].y + V[j].z * V[j].z + V[j].w * V[j].w; \
    ss = wave_sum(ss); \
    const float rstd = rsqrtf(ss * (1.0f / DM) + 1e-6f); \
    UFOR(j, 8) { \
      const int c = j * 256 + lane * 4; \
      const float4 gg = *(const float4*)(g + c); \
      float4 o; o.x = V[j].x * rstd * gg.x; o.y = V[j].y * rstd * gg.y; o.z = V[j].z * rstd * gg.z; o.w = V[j].w * rstd * gg.w; \
      *(float4*)(src + c) = o; } }
  int r = bid_ * 8 + wv;
  if (r < ML) FIN_LOAD(va, r);
  for (; r < ML; r += 2 * stride) {
    if (r + stride < ML) FIN_LOAD(vb, r + stride);
    FIN_BODY(va, r);
    if (r + 2 * stride < ML) FIN_LOAD(va, r + 2 * stride);
    if (r + stride < ML) FIN_BODY(vb, r + stride);
  }
#undef FIN_LOAD
#undef FIN_BODY
}

constexpr int BM = 256, BK = 64, HALF = 128, NXCD = 8, WGM = 4, HT = HALF * BK;
__device__ __forceinline__ int lds_byte(int r, int c) {
  int st = (r >> 4) * 2 + (c >> 5), rr = r & 15, cc = c & 31, ob = rr * 64 + cc * 2;
  return st * 1024 + (ob ^ (((ob >> 9) & 1) << 5));
}
__device__ __forceinline__ void stage_rc(int b, int& R, int& C) {
  int st = b / 1024, sb = b % 1024, swz = sb ^ (((sb >> 9) & 1) << 5);
  R = (st >> 1) * 16 + swz / 64; C = (st & 1) * 32 + (swz % 64) / 2;
}

enum { EPI_Z = 0, EPI_RES = 1, EPI_UPG = 2, EPI_PART = 3 };
struct EpiArgs {
  u16* zrw; u16* zcr;
  const float* srcL; const float* srcC; float* dstL; float* dstC; const float* gate;
  u16* h2; const float* cw;
  float* part;
};

template <int EPI, int K, int KL>
__device__ __forceinline__ void gemm_tile(const u16* __restrict__ A, const u16* __restrict__ Bt, const long brow, const int bcol,
                          const int pn, const int seq0, const int seq1, const EpiArgs& e,
                          const bool own_prologue, const bool has_next, const long nbrow, const int nbcol) {
  const int tid_ = tidx(); const int bid_ = bidx(); (void)bid_;
  u16* shm = (u16*)smem;
#define SA(b, h) (shm + ((b) * 2 + (h)) * HT)
#define SB(b, h) (shm + (4 + (b) * 2 + (h)) * HT)
#define STAGE(P, BASE, br, kt) STAGET(tid_, P, BASE, br, kt)
#define STAGET(TT, P, BASE, br, kt)                                                                              \
  do {                                                                                                      \
    long _g = (long)(br) * K + (long)(kt) * BK;                                                             \
    UFOR(_i, 2) {                                                                        \
      int _b = (TT) * 16 + _i * 8192; int _r, _c; stage_rc(_b, _r, _c);                              \
      __builtin_amdgcn_global_load_lds((const unsigned*)(BASE + _g + (long)_r * K + _c),                    \
                                       (__attribute__((address_space(3))) unsigned*)((char*)(P) + _b), 16, 0, 0); \
    }                                                                                                       \
  } while (0)
#define LDA(dst, b, h) UFOR(m, 4) UFOR(k, 2) \
    dst[m][k] = *reinterpret_cast<const bf16x8*>((char*)SA(b, h) + lds_byte(wr * 64 + m * 16 + fr, k * 32 + fq * 8))
#define LDB(dst, b, h) UFOR(n, 2) UFOR(k, 2) \
    dst[n][k] = *reinterpret_cast<const bf16x8*>((char*)SB(b, h) + lds_byte(wc * 32 + n * 16 + fr, k * 32 + fq * 8))
#define MMA(ai, bj, At, Bq) do { __builtin_amdgcn_s_setprio(1); \
    UFOR(m, 4) UFOR(n, 2) UFOR(k, 2) \
      acc[ai][bj][m][n] = __builtin_amdgcn_mfma_f32_16x16x32_bf16(Bq[n][k], At[m][k], acc[ai][bj][m][n], 0, 0, 0); \
    __builtin_amdgcn_s_setprio(0); } while (0)
#define WAIT_V(n) asm volatile("s_waitcnt vmcnt(" #n ")" ::: "memory")
#define WAIT_L(n) asm volatile("s_waitcnt lgkmcnt(" #n ")" ::: "memory")
#define BAR __builtin_amdgcn_s_barrier()
#define SCHED __builtin_amdgcn_sched_barrier(0)
  const int wid = tid_ >> 6, lane = tid_ & 63, wr = wid >> 2, wc = wid & 3, fr = lane & 15, fq = lane >> 4;
  f32x4 acc[2][2][4][2] = {};
  bf16x8 At[4][2], B0[2][2], B1[2][2];
  const int nt = KL / BK;
  if (own_prologue) {
    STAGE(SB(0, 0), Bt, bcol, 0); STAGE(SA(0, 0), A, brow, 0);
    STAGE(SB(0, 1), Bt, bcol + HALF, 0); STAGE(SA(0, 1), A, brow + HALF, 0);
  }
  if (wr == 1) BAR;
  WAIT_V(4); BAR;
  STAGE(SB(1, 0), Bt, bcol, 1); STAGE(SA(1, 0), A, brow, 1); STAGE(SB(1, 1), Bt, bcol + HALF, 1);
  WAIT_V(6); BAR;
  for (int t = 0; t < nt - 2; t += 2) {
    LDB(B0, 0, 0); SCHED; LDA(At, 0, 0); STAGE(SA(1, 1), A, brow + HALF, t + 1);
    WAIT_L(8); BAR; WAIT_L(0); MMA(0, 0, At, B0); BAR; SCHED;
    LDB(B1, 0, 1); STAGE(SB(0, 0), Bt, bcol, t + 2);
    BAR; WAIT_L(0); MMA(0, 1, At, B1); BAR;
    LDA(At, 0, 1); STAGE(SA(0, 0), A, brow, t + 2);
    BAR; WAIT_L(0); MMA(1, 0, At, B0); BAR; SCHED;
    STAGE(SB(0, 1), Bt, bcol + HALF, t + 2);
    WAIT_V(6); BAR; MMA(1, 1, At, B1); BAR;
    LDB(B0, 1, 0); SCHED; LDA(At, 1, 0); STAGE(SA(0, 1), A, brow + HALF, t + 2);
    WAIT_L(8); BAR; WAIT_L(0); MMA(0, 0, At, B0); BAR; SCHED;
    LDB(B1, 1, 1); STAGE(SB(1, 0), Bt, bcol, t + 3);
    BAR; WAIT_L(0); MMA(0, 1, At, B1); BAR;
    LDA(At, 1, 1); STAGE(SA(1, 0), A, brow, t + 3);
    BAR; WAIT_L(0); MMA(1, 0, At, B0); BAR; SCHED;
    STAGE(SB(1, 1), Bt, bcol + HALF, t + 3);
    WAIT_V(6); BAR; MMA(1, 1, At, B1); BAR;
  }
  { LDB(B0, 0, 0); LDA(At, 0, 0); STAGE(SA(1, 1), A, brow + HALF, nt - 1);
    BAR; WAIT_L(0); MMA(0, 0, At, B0); BAR;
    LDB(B1, 0, 1); BAR; WAIT_L(0); MMA(0, 1, At, B1); BAR;
    LDA(At, 0, 1); WAIT_V(4); BAR; WAIT_L(0); MMA(1, 0, At, B0); MMA(1, 1, At, B1); BAR; }
  { LDB(B0, 1, 0); LDA(At, 1, 0); WAIT_V(2); BAR; WAIT_L(0); MMA(0, 0, At, B0); BAR;
    LDB(B1, 1, 1); WAIT_V(0); BAR; WAIT_L(0); MMA(0, 1, At, B1); BAR;
    LDA(At, 1, 1); BAR; WAIT_L(0); MMA(1, 0, At, B0); MMA(1, 1, At, B1); BAR; }
  if (wr == 0) BAR;
  if (EPI != EPI_UPG && EPI != EPI_PART && has_next) {
    int t2 = tid_; asm volatile("" : "+v"(t2));
    STAGET(t2, SB(0, 0), Bt, nbcol, 0); STAGET(t2, SA(0, 0), A, nbrow, 0);
    STAGET(t2, SB(0, 1), Bt, nbcol + HALF, 0); STAGET(t2, SA(0, 1), A, nbrow + HALF, 0);
  }
  if (EPI == EPI_Z) {
    u16* dst; int ld, c0;
    if (bcol < RWC) { dst = e.zrw; ld = RWC; c0 = bcol; } else { dst = e.zcr; ld = CRC; c0 = bcol - RWC; }
    UFOR(ai, 2) UFOR(bj, 2) UFOR(m, 4) {
      const f32x4 a = acc[ai][bj][m][0], b = acc[ai][bj][m][1];
      uint4 pk; pk.x = pk2(a[0], a[1]); pk.y = pk2(a[2], a[3]); pk.z = pk2(b[0], b[1]); pk.w = pk2(b[2], b[3]);
      *(uint4*)(dst + (size_t)(brow + ai * HALF + wr * 64 + m * 16 + fr) * ld + (c0 + bj * HALF + wc * 32 + fq * 8)) = pk;
    }
  } else if (EPI == EPI_RES) {
    const float* src; float* dst; const float* gt; long r0 = brow;
    if (brow < ML) { src = e.srcL; dst = e.dstL; gt = e.gate + (size_t)(brow >> 14) * 12288; }
    else { src = e.srcC; dst = e.dstC; gt = e.gate + (size_t)2 * 12288; r0 = brow - ML; }
    UFOR(bj, 2) UFOR(n, 2) {
      const int c = bcol + bj * HALF + wc * 32 + fq * 8 + n * 4;
      const float4 gv = *(const float4*)(gt + c);
      UFOR(ai, 2) {
        UFOR(m, 4) {
          const size_t idx = (size_t)(r0 + ai * HALF + wr * 64 + m * 16 + fr) * DM + c;
          float4 s = *(const float4*)(src + idx);
          const f32x4 a = acc[ai][bj][m][n];
          s.x += gv.x * a[0]; s.y += gv.y * a[1]; s.z += gv.z * a[2]; s.w += gv.w * a[3];
          *(float4*)(dst + idx) = s;
        }
        __builtin_amdgcn_sched_barrier(0);
      }
    }
  } else if (EPI == EPI_PART) {
    const long r0 = brow - ML;
    UFOR(ai, 2) UFOR(bj, 2) UFOR(m, 4) UFOR(n, 2) {
      const f32x4 a = acc[ai][bj][m][n];
      *(float4*)(e.part + (size_t)(r0 + ai * HALF + wr * 64 + m * 16 + fr) * DM + (bcol + bj * HALF + wc * 32 + fq * 8 + n * 4)) = make_float4(a[0], a[1], a[2], a[3]);
    }
  } else {
    u16* U = (u16*)smem;
    LDS_BARRIER();
    UFOR(ai, 2) UFOR(bj, 2) UFOR(m, 4) {
      const f32x4 a = acc[ai][bj][m][0], b = acc[ai][bj][m][1];
      uint4 pk; pk.x = pk2(a[0], a[1]); pk.y = pk2(a[2], a[3]); pk.z = pk2(b[0], b[1]); pk.w = pk2(b[2], b[3]);
      *(uint4*)(U + (ai * HALF + wr * 64 + m * 16 + fr) * 256 + bj * 128 + wc * 32 + fq * 8) = pk;
    }
    LDS_BARRIER();
    {
      const int c4 = (tid_ & 31) * 4, rb = tid_ >> 5;
      const int gc = pn * 128 + c4;
      float wg[4][3], wv[4][3];
      UFOR(q, 4) UFOR(x, 3) { wg[q][x] = e.cw[(size_t)(gc + q) * 3 + x]; wv[q][x] = e.cw[(size_t)(DFF + gc + q) * 3 + x]; }
      float pg[4], cgv[4], ng[4], pvv[4], cv[4], nv[4];
      const int lr0 = rb * 16;
      {
        const int lrp = lr0 > 0 ? lr0 - 1 : 0;
        const uint2 a = *(const uint2*)(U + lrp * 256 + c4), b = *(const uint2*)(U + lrp * 256 + 128 + c4);
        pg[0] = lo2f(a.x); pg[1] = hi2f(a.x); pg[2] = lo2f(a.y); pg[3] = hi2f(a.y);
        pvv[0] = lo2f(b.x); pvv[1] = hi2f(b.x); pvv[2] = lo2f(b.y); pvv[3] = hi2f(b.y);
        const uint2 c = *(const uint2*)(U + lr0 * 256 + c4), d = *(const uint2*)(U + lr0 * 256 + 128 + c4);
        cgv[0] = lo2f(c.x); cgv[1] = hi2f(c.x); cgv[2] = lo2f(c.y); cgv[3] = hi2f(c.y);
        cv[0] = lo2f(d.x); cv[1] = hi2f(d.x); cv[2] = lo2f(d.y); cv[3] = hi2f(d.y);
      }
#pragma unroll 2
      for (int q = 0; q < 16; ++q) {
        const int lr = lr0 + q;
        const int lrn = lr < 255 ? lr + 1 : 255;
        const uint2 a = *(const uint2*)(U + lrn * 256 + c4), b = *(const uint2*)(U + lrn * 256 + 128 + c4);
        ng[0] = lo2f(a.x); ng[1] = hi2f(a.x); ng[2] = lo2f(a.y); ng[3] = hi2f(a.y);
        nv[0] = lo2f(b.x); nv[1] = hi2f(b.x); nv[2] = lo2f(b.y); nv[3] = hi2f(b.y);
        const long gr = brow + lr;
        const bool valid = (gr >= seq0) && (gr < seq1) && (lr >= 1 || gr == seq0) && (lr <= 254 || gr == seq1 - 1);
        if (valid) {
          const float mp = (gr - 1 >= seq0) ? 1.f : 0.f, mn = (gr + 1 < seq1) ? 1.f : 0.f;
          float o[4];
          UFOR(x, 4) {
            const float g = wg[x][0] * pg[x] * mp + wg[x][1] * cgv[x] + wg[x][2] * ng[x] * mn;
            const float v = wv[x][0] * pvv[x] * mp + wv[x][1] * cv[x] + wv[x][2] * nv[x] * mn;
            o[x] = siluf_(g) * v;
          }
          uint2 pk; pk.x = pk2(o[0], o[1]); pk.y = pk2(o[2], o[3]);
          *(uint2*)(e.h2 + (size_t)gr * DFF + gc) = pk;
        }
        UFOR(x, 4) { pg[x] = cgv[x]; cgv[x] = ng[x]; pvv[x] = cv[x]; cv[x] = nv[x]; }
      }
    }
    LDS_BARRIER();
    if (has_next) {
      int t2 = tid_; asm volatile("" : "+v"(t2));
      STAGET(t2, SB(0, 0), Bt, nbcol, 0); STAGET(t2, SA(0, 0), A, nbrow, 0);
      STAGET(t2, SB(0, 1), Bt, nbcol + HALF, 0); STAGET(t2, SA(0, 1), A, nbrow + HALF, 0);
    }
  }
#undef SA
#undef SB
}

template <int EPI>
__device__ __forceinline__ void tile_coords(int L, int nM, int nN, long& brow, int& pn, int& seq0, int& seq1) {
  const int nwg = nM * nN;
  int wgid = L;
  { const int q = nwg / NXCD, r = nwg % NXCD, xcd = wgid % NXCD, off = wgid / NXCD; wgid = (xcd < r ? xcd * (q + 1) : r * (q + 1) + (xcd - r) * q) + off; }
  const int nig = WGM * nN, gid = wgid / nig, fm = gid * WGM, gsz = (nM - fm) < WGM ? (nM - fm) : WGM;
  const int pm = fm + ((wgid % nig) % gsz);
  pn = (wgid % nig) / gsz;
  seq0 = 0; seq1 = 0;
  if (EPI == EPI_UPG) {
    if (pm < 130) { const int s = pm / 65, i = pm % 65; seq0 = s * TL; seq1 = seq0 + TL; brow = seq0 + 254 * i - 1; }
    else { const int s = pm - 130; seq0 = ML + s * CTX; seq1 = seq0 + CTX; brow = seq0; }
  } else brow = (long)pm * BM;
}
template <int EPI, int K>
__device__ __forceinline__ void gemm_phase(const u16* A, const u16* Bt, int nM, int nN, const EpiArgs& e) {
  const int tid_ = tidx(); const int bid_ = bidx(); (void)bid_; (void)tid_;
  const int nwg = nM * nN, G = gridDim.x;
  long brow = 0, nbrow = 0; int pn = 0, seq0 = 0, seq1 = 0, npn = 0, nseq0 = 0, nseq1 = 0;
  if (bid_ < nwg) tile_coords<EPI>(bid_, nM, nN, brow, pn, seq0, seq1);
  bool first = true;
  for (int L = bid_; L < nwg; L += G) {
    const bool has_next = (L + G) < nwg;
    if (has_next) tile_coords<EPI>(L + G, nM, nN, nbrow, npn, nseq0, nseq1);
    gemm_tile<EPI, K, K>(A, Bt, brow, pn * BM, pn, seq0, seq1, e, first, has_next, nbrow, npn * BM);
    first = false;
    brow = nbrow; pn = npn; seq0 = nseq0; seq1 = nseq1;
  }
  __syncthreads();
}

#define OFF_P2 (832 * MIB)
#define P2_PARTS 11
__device__ __forceinline__ void gemm_ctx_splitk_down(const u16* A, const u16* Bt, float* P2, const EpiArgs& e0) {
  const int tid_ = tidx(); const int bid_ = bidx(); (void)tid_;
  for (int u = bid_; u < 16 * P2_PARTS; u += gridDim.x) {
    const int tile = u / P2_PARTS, part = u % P2_PARTS, pm = 128 + (tile >> 3), pn = tile & 7;
    EpiArgs e = e0; e.part = P2 + (size_t)part * 512 * DM;
    const long koff = (long)part * (DFF / P2_PARTS);
    gemm_tile<EPI_PART, DFF, DFF / P2_PARTS>(A + koff, Bt + koff, (long)pm * BM, pn * BM, pn, 0, 0, e, true, false, 0, 0);
  }
  __syncthreads();
}

#define R_QS 0
#define R_KS 17408
#define R_KT 34816
#define R_VT 53248
#define R_SS 71680
#define R_RT 80896
#define R_KT2 34816
#define R_KT2B 71680
__device__ __forceinline__ float lg_gamma(int h, int dir) { return log1pf(-exp2f(-(dir ? 5.5f : 5.0f) - (float)h)); }

__device__ __forceinline__ bf16x8 ldsfrag(int base, int row, int ldb, int kel) {
  return *(const bf16x8*)(smem + base + row * ldb + kel * 2);
}
#define MFMA16(a, b, c) __builtin_amdgcn_mfma_f32_16x16x32_bf16(a, b, c, 0, 0, 0)
__device__ __forceinline__ bf16x8 ldsfrag_sw(int base, int row, int ks, int fq) {
  return *(const bf16x8*)(smem + base + row * 144 + ((((ks << 2) | fq) ^ ((row >> 3) & 7)) << 4));
}
#define LDSFRAG_SWN(base, N, ks, pl0, pl1, rowoff) \
  (*(const bf16x8*)(smem + (base) + (rowoff) + (N) * 2304 + ((((ks) ^ (((N) >> 1) & 1)) << 6)) + (((N) & 1) ? (pl1) : (pl0))))

#define R_TAB 115712
struct RetRaw { uint4 q1, q2, k1, k2, v1, v2; float4 c0, c1, s0, s1; };
__device__ __forceinline__ void ret_issue(KP p, RetRaw& R, int tid_, int mode, int base, int rev, int h, int rope, int t0) {
  const u16* zcr = (const u16*)(p->ws + OFF_ZCR);
  const float* rc = (const float*)(p->ws + OFF_ROPE);
  const float* rs = rc + TL * 64;
  const int i = tid_ >> 3, g = tid_ & 7;
  const int nr = rev ? (base + 63 - i) : (base + i);
  const u16* zr = zcr + (size_t)nr * CRC + 1536 + h * 128;
  R.k1 = *(const uint4*)(zr + 768 + g * 8); R.k2 = *(const uint4*)(zr + 768 + 64 + g * 8);
  R.v1 = *(const uint4*)(zr + 1536 + g * 8); R.v2 = *(const uint4*)(zr + 1536 + 64 + g * 8);
  if (mode == 0) { R.q1 = *(const uint4*)(zr + g * 8); R.q2 = *(const uint4*)(zr + 64 + g * 8); }
  if (rope) {
    const int t = t0 + (rev ? (63 - i) : i);
    const float* cp = rc + (size_t)t * 64 + g * 8; const float* sp = rs + (size_t)t * 64 + g * 8;
    R.c0 = *(const float4*)cp; R.c1 = *(const float4*)(cp + 4); R.s0 = *(const float4*)sp; R.s1 = *(const float4*)(sp + 4);
  }
}
__device__ __forceinline__ void ret_stage(const RetRaw& R, int tid_, int mode, int rope, float zf, float zb) {
  const int i = tid_ >> 3, g = tid_ & 7;
  float q1[8], q2[8], k1[8], k2[8], v1[8], v2[8];
  unpack8(R.k1, k1); unpack8(R.k2, k2); unpack8(R.v1, v1); unpack8(R.v2, v2);
  if (mode == 0) { unpack8(R.q1, q1); unpack8(R.q2, q2); }
  if (rope) {
    const float cc[8] = {R.c0.x, R.c0.y, R.c0.z, R.c0.w, R.c1.x, R.c1.y, R.c1.z, R.c1.w};
    const float ss[8] = {R.s0.x, R.s0.y, R.s0.z, R.s0.w, R.s1.x, R.s1.y, R.s1.z, R.s1.w};
    UFOR(x, 8) {
      const float c = cc[x], s = ss[x];
      const float a = k1[x], b = k2[x]; k1[x] = a * c - b * s; k2[x] = a * s + b * c;
      if (mode == 0) { const float a2 = q1[x], b2 = q2[x]; q1[x] = a2 * c - b2 * s; q2[x] = a2 * s + b2 * c; }
    }
  }
  u16* VT = (u16*)(smem + R_VT);
  const int isw = i ^ (g << 3);
  UFOR(x, 8) { VT[(g * 8 + x) * 72 + isw] = f2bf(v1[x]); VT[(64 + g * 8 + x) * 72 + isw] = f2bf(v2[x]); }
  u16* KT = (u16*)(smem + R_KT);
  UFOR(x, 8) { KT[(g * 8 + x) * 72 + isw] = f2bf(k1[x] * zf); KT[(64 + g * 8 + x) * 72 + isw] = f2bf(k2[x] * zf); }
  if (mode == 1) {
    u16* KB = (u16*)(smem + R_KT2B);
    UFOR(x, 8) { KB[(g * 8 + x) * 72 + isw] = f2bf(k1[x] * zb); KB[(64 + g * 8 + x) * 72 + isw] = f2bf(k2[x] * zb); }
  } else {
    const float sc = 0.08838834764831845f;
    UFOR(x, 8) { q1[x] *= sc; q2[x] *= sc; }
    *(uint4*)(smem + R_QS + i * 272 + g * 16) = pack8(q1); *(uint4*)(smem + R_QS + i * 272 + 128 + g * 16) = pack8(q2);
    *(uint4*)(smem + R_KS + i * 272 + g * 16) = pack8(k1); *(uint4*)(smem + R_KS + i * 272 + 128 + g * 16) = pack8(k2);
  }
}

#define NSEG 21
__device__ __forceinline__ int seg_c0(int s) { return (s * 256) / NSEG; }
__device__ __forceinline__ void phase_ret_summaries(KP p) {
  const int tid_ = tidx(); const int bid_ = bidx(); (void)bid_;
  p = kp_launder(p);
  float* KV = (float*)(p->ws + OFF_KV);
  const int lane = tid_ & 63, w = tid_ >> 6, fr = lane & 15, fq = lane >> 4;
  const int ti = tid_ >> 3;
  const int pl0 = fr * 144 + ((fq ^ (fr >> 3)) << 4), pl1 = fr * 144 + (((fq ^ (fr >> 3)) ^ 2) << 4);
  int it_step = gridDim.x;
  if ((int)gridDim.x > 12 * NSEG) it_step = (bid_ >= 12 * NSEG) ? ((int)gridDim.x - 12 * NSEG) : 12 * (NSEG + 1);
  for (int it = bid_; it < 12 * (NSEG + 1); it += it_step) {
    int bh, seg;
    if (it < 12 * NSEG) { bh = it / NSEG; seg = it % NSEG; } else { bh = it - 12 * NSEG; seg = NSEG; }
    const int b = bh / 6, h = bh % 6;
    const int isctx = seg == NSEG;
    const int c0 = seg_c0(seg), tseg0 = c0 * 64;
    const int L = isctx ? CTX : (seg_c0(seg + 1) - c0) * 64;
    const int n0 = isctx ? (ML + b * CTX) : (b * TL + tseg0);
    const float lgf = lg_gamma(h, 0), lgb = lg_gamma(h, 1);
    f32x4 af[8], ab[8];
    UFOR(n, 8) { af[n] = (f32x4){0.f, 0.f, 0.f, 0.f}; ab[n] = af[n]; }
    RetRaw R;
    ret_issue(p, R, tid_, 1, n0, 0, h, !isctx, tseg0);
    const int nsc = L / 64;
    for (int sc = 0; sc < nsc; ++sc) {
      LDS_BARRIER();
      ret_stage(R, tid_, 1, !isctx, expf(lgf * (float)(L - 1 - sc * 64 - ti)), expf(lgb * (float)(sc * 64 + ti)));
      if (sc + 1 < nsc) ret_issue(p, R, tid_, 1, n0 + (sc + 1) * 64, 0, h, !isctx, tseg0 + (sc + 1) * 64);
      LDS_BARRIER();
      UFOR(ks, 2) {
        const bf16x8 a = ldsfrag_sw(R_VT, w * 16 + fr, ks, fq);
        UFOR(n, 8) {
          af[n] = MFMA16(LDSFRAG_SWN(R_KT, n, ks, pl0, pl1, 0), a, af[n]);
          ab[n] = MFMA16(LDSFRAG_SWN(R_KT2B, n, ks, pl0, pl1, 0), a, ab[n]);
        }
      }
    }
    f32x4* of = (f32x4*)(KV + (((size_t)(bh * 2 + 0) * (NSEG + 1) + seg) * 512 + tid_) * 32);
    f32x4* ob = (f32x4*)(KV + (((size_t)(bh * 2 + 1) * (NSEG + 1) + seg) * 512 + tid_) * 32);
    UFOR(n, 8) { of[n] = af[n]; ob[n] = ab[n]; }
  }
}

__device__ __forceinline__ void ret_pass(KP p, int tid_, int dir, int n0, int nch, int h, int rope, int tseg0, f32x4* RT, float* scr) {
  const int lane = tid_ & 63, w = tid_ >> 6, fr = lane & 15, fq = lane >> 4;
  const int mt = w >> 1, nh = w & 1;
  const int pl0 = fr * 144 + ((fq ^ (fr >> 3)) << 4), pl1 = fr * 144 + (((fq ^ (fr >> 3)) ^ 2) << 4);
  const float* pw = (const float*)(smem + R_TAB) + dir * 65;
  const float g64 = pw[64];
  RetRaw R;
  { const int nc0 = dir ? (nch - 1) : 0; ret_issue(p, R, tid_, 0, n0 + nc0 * 64, dir, h, rope, tseg0 + nc0 * 64); }
  for (int cc = 0; cc < nch; ++cc) {
    const int nc = dir ? (nch - 1 - cc) : cc;
    LDS_BARRIER();
    UFOR(n, 8) {
      uint2 pk; pk.x = pk2(RT[n][0], RT[n][1]); pk.y = pk2(RT[n][2], RT[n][3]);
      *(uint2*)(smem + R_RT + (w * 16 + fr) * 272 + (n * 16 + fq * 4) * 2) = pk;
    }
    ret_stage(R, tid_, 0, rope, pw[63 - (tid_ >> 3)], 0.f);
    if (cc + 1 < nch) { const int nn = dir ? (nch - 2 - cc) : (cc + 1); ret_issue(p, R, tid_, 0, n0 + nn * 64, dir, h, rope, tseg0 + nn * 64); }
    float yprev[4][4];
    if (!dir) {
      UFOR(n, 4) UFOR(j, 4) { const int i = mt * 16 + fq * 4 + j; yprev[n][j] = scr[(size_t)(nc * 64 + i) * 128 + (nh * 4 + n) * 16 + fr]; }
    }
    LDS_BARRIER();
    f32x4 s[2] = {(f32x4){0.f, 0.f, 0.f, 0.f}, (f32x4){0.f, 0.f, 0.f, 0.f}};
    UFOR(ks, 4) {
      const bf16x8 a = ldsfrag(R_QS, mt * 16 + fr, 272, ks * 32 + fq * 8);
      UFOR(n, 2) s[n] = MFMA16(a, ldsfrag(R_KS, (nh * 2 + n) * 16 + fr, 272, ks * 32 + fq * 8), s[n]);
    }
    UFOR(n, 2) UFOR(j, 4) {
      const int i = mt * 16 + fq * 4 + j, m = (nh * 2 + n) * 16 + fr;
      const int df = i - m;
      float v = 0.f;
      if (dir ? (df > 0) : (df >= 0)) v = s[n][j] * pw[df];
      *(u16*)(smem + R_SS + i * 144 + m * 2) = f2bf(v);
    }
    f32x4 y[4];
    UFOR(n, 4) y[n] = (f32x4){0.f, 0.f, 0.f, 0.f};
    UFOR(ks, 4) {
      const bf16x8 a = ldsfrag(R_QS, mt * 16 + fr, 272, ks * 32 + fq * 8);
      UFOR(n, 4) y[n] = MFMA16(a, ldsfrag(R_RT, (nh * 4 + n) * 16 + fr, 272, ks * 32 + fq * 8), y[n]);
    }
    UFOR(j, 4) {
      const float xi = pw[mt * 16 + fq * 4 + j + 1];
      UFOR(n, 4) y[n][j] *= xi;
    }
    LDS_BARRIER();
    UFOR(ks, 2) {
      const bf16x8 a = ldsfrag(R_SS, mt * 16 + fr, 144, ks * 32 + fq * 8);
      UFOR(n, 4) y[n] = MFMA16(a, LDSFRAG_SWN(R_VT, n, ks, pl0, pl1, nh * 9216), y[n]);
    }
    UFOR(n, 8) UFOR(j, 4) RT[n][j] *= g64;
    UFOR(ks, 2) {
      const bf16x8 a = ldsfrag_sw(R_VT, w * 16 + fr, ks, fq);
      UFOR(n, 8) RT[n] = MFMA16(LDSFRAG_SWN(R_KT, n, ks, pl0, pl1, 0), a, RT[n]);
    }
    UFOR(n, 4) UFOR(j, 4) {
      const int i = mt * 16 + fq * 4 + j;
      const int tl = nc * 64 + (dir ? (63 - i) : i);
      float* d = scr + (size_t)tl * 128 + (nh * 4 + n) * 16 + fr;
      if (dir) *d = y[n][j]; else *d = y[n][j] + yprev[n][j];
    }
  }
}

__device__ __forceinline__ void phase_ret_out(KP p, int l, int with_ctx) {
  const int tid_ = tidx(); const int bid_ = bidx(); (void)bid_;
  p = kp_launder(p);
  const float* KV = (const float*)(p->ws + OFF_KV);
  float* scr = (float*)(p->ws + OFF_SCR) + (size_t)bid_ * 106496;
  u16* mix = (u16*)(p->ws + OFF_A);
  const u16* zcr = (const u16*)(p->ws + OFF_ZCR);
  const float* rng = p->in[21] + (size_t)l * RW;
  const int lane = tid_ & 63, w = tid_ >> 6;
  const int nitems = 12 * (with_ctx ? NSEG + 1 : NSEG);
  int it_step = gridDim.x;
  if ((int)gridDim.x > 12 * NSEG) it_step = (bid_ >= 12 * NSEG) ? ((int)gridDim.x - 12 * NSEG) : 12 * (NSEG + 1);
  for (int it = bid_; it < nitems; it += it_step) {
    int bh, seg;
    if (it < 12 * NSEG) { bh = it / NSEG; seg = it % NSEG; } else { bh = it - 12 * NSEG; seg = NSEG; }
    const int b = bh / 6, h = bh % 6;
    const int isctx = seg == NSEG;
    const int c0 = seg_c0(seg), tseg0 = c0 * 64;
    const int nch = isctx ? 4 : (seg_c0(seg + 1) - c0);
    const int n0 = isctx ? (ML + b * CTX) : (b * TL + tseg0);
    const float lgf = lg_gamma(h, 0), lgb = lg_gamma(h, 1);
    __syncthreads();
    if (tid_ < 130) { const int d = tid_ / 65, e = tid_ % 65; ((float*)(smem + R_TAB))[tid_] = expf((d ? lgb : lgf) * (float)e); }
    __syncthreads();
    f32x4 RT[8];
    UFOR(n, 8) RT[n] = (f32x4){0.f, 0.f, 0.f, 0.f};
    if (!isctx) {
      const float g12 = expf(lgb * 768.f), g13 = expf(lgb * 832.f);
      const f32x4* base = (const f32x4*)(KV + ((size_t)(bh * 2 + 1) * (NSEG + 1) * 512 + tid_) * 32);
      UFOR(n, 8) RT[n] = base[(size_t)NSEG * 4096 + n];
#pragma unroll 2
      for (int s = NSEG - 1; s > seg; --s) {
        f32x4 t[8];
        UFOR(n, 8) t[n] = base[(size_t)s * 4096 + n];
        const float gL = (seg_c0(s + 1) - seg_c0(s)) == 13 ? g13 : g12;
        UFOR(n, 8) RT[n] = RT[n] * gL + t[n];
      }
    }
    ret_pass(p, tid_, 1, n0, nch, h, !isctx, tseg0, RT, scr);
    __syncthreads();
    UFOR(n, 8) RT[n] = (f32x4){0.f, 0.f, 0.f, 0.f};
    if (!isctx) {
      const float g12 = expf(lgf * 768.f), g13 = expf(lgf * 832.f);
      const f32x4* base = (const f32x4*)(KV + ((size_t)(bh * 2 + 0) * (NSEG + 1) * 512 + tid_) * 32);
      UFOR(n, 8) RT[n] = base[(size_t)NSEG * 4096 + n];
#pragma unroll 2
      for (int s = 0; s < seg; ++s) {
        f32x4 t[8];
        UFOR(n, 8) t[n] = base[(size_t)s * 4096 + n];
        const float gL = (seg_c0(s + 1) - seg_c0(s)) == 13 ? g13 : g12;
        UFOR(n, 8) RT[n] = RT[n] * gL + t[n];
      }
    }
    ret_pass(p, tid_, 0, n0, nch, h, !isctx, tseg0, RT, scr);
    __syncthreads();
    {
      const int ntw = nch * 8;
      const float rg0 = rng[h * 128 + lane], rg1 = rng[h * 128 + 64 + lane];
      for (int k0 = 0; k0 < ntw; k0 += 8) {
        float v0[8], v1[8]; u16 g0[8], g1[8];
        UFOR(u, 8) {
          const int tl = w * ntw + k0 + u;
          const size_t row = (size_t)(n0 + tl);
          v0[u] = scr[(size_t)tl * 128 + lane]; v1[u] = scr[(size_t)tl * 128 + 64 + lane];
          g0[u] = zcr[row * CRC + 1536 + 2304 + h * 128 + lane]; g1[u] = zcr[row * CRC + 1536 + 2304 + h * 128 + 64 + lane];
        }
        UFOR(u, 8) {
          const int tl = w * ntw + k0 + u;
          const size_t row = (size_t)(n0 + tl);
          const float mu = wave_sum(v0[u] + v1[u]) * (1.f / 128.f);
          const float d0 = v0[u] - mu, d1 = v1[u] - mu;
          const float var = wave_sum(d0 * d0 + d1 * d1) * (1.f / 128.f);
          const float rstd = rsqrtf(var + 1e-6f);
          mix[row * DM + 1280 + h * 128 + lane] = f2bf(siluf_(bf2f(g0[u])) * d0 * rstd * rg0);
          mix[row * DM + 1280 + h * 128 + 64 + lane] = f2bf(siluf_(bf2f(g1[u])) * d1 * rstd * rg1);
        }
      }
    }
    __syncthreads();
  }
}

__device__ __forceinline__ void phase_convmix(KP p, int l, int nrows) {
  const int tid_ = tidx(); const int bid_ = bidx(); (void)bid_;
  p = kp_launder(p);
  const u16* zcr = (const u16*)(p->ws + OFF_ZCR);
  u16* mix = (u16*)(p->ws + OFF_A);
  const float* cw = p->in[20] + (size_t)l * 512 * 3;
  const int total = nrows * 64;
  for (int i = bid_ * NTHREADS + tid_; i < total; i += gridDim.x * NTHREADS) {
    const int r = i >> 6, c = (i & 63) * 8;
    int s0, len, mr; seqinfo(r, s0, len, mr);
    const u16* z = zcr + (size_t)r * CRC;
    float gb[8], cc[8], hh[8], pm[8], pp[8], t1[8], t2[8];
    unpack8(*(const uint4*)(z + c), gb);
    unpack8(*(const uint4*)(z + 512 + c), cc); unpack8(*(const uint4*)(z + 1024 + c), hh);
    UFOR(x, 8) { cc[x] *= hh[x]; pm[x] = 0.f; pp[x] = 0.f; }
    if (r - 1 >= s0) { unpack8(*(const uint4*)(z - CRC + 512 + c), t1); unpack8(*(const uint4*)(z - CRC + 1024 + c), t2); UFOR(x, 8) pm[x] = t1[x] * t2[x]; }
    if (r + 1 < s0 + len) { unpack8(*(const uint4*)(z + CRC + 512 + c), t1); unpack8(*(const uint4*)(z + CRC + 1024 + c), t2); UFOR(x, 8) pp[x] = t1[x] * t2[x]; }
    float o[8];
    UFOR(x, 8) o[x] = gb[x] * (pm[x] * cw[(c + x) * 3] + cc[x] * cw[(c + x) * 3 + 1] + pp[x] * cw[(c + x) * 3 + 2]);
    *(uint4*)(mix + (size_t)r * DM + 768 + c) = pack8(o);
  }
}

#define FA(i) ((u16*)(p->ws + OFF_FEAT + (size_t)(i) * FEAT_SZ))
#define F_AIN 0
#define F_KL 8448
#define F_KK 33024
#define F_RL 57600
#define F_SB 82176
#define F_STG 82944
__device__ __forceinline__ uint4 packh8(const float* f) {
  uint4 u;
  u.x = (unsigned)f2h(f[0]) | ((unsigned)f2h(f[1]) << 16); u.y = (unsigned)f2h(f[2]) | ((unsigned)f2h(f[3]) << 16);
  u.z = (unsigned)f2h(f[4]) | ((unsigned)f2h(f[5]) << 16); u.w = (unsigned)f2h(f[6]) | ((unsigned)f2h(f[7]) << 16);
  return u;
}
__device__ __forceinline__ void ld8f(const float* p_, float* f) {
  const float4 a = *(const float4*)p_, b = *(const float4*)(p_ + 4);
  f[0] = a.x; f[1] = a.y; f[2] = a.z; f[3] = a.w; f[4] = b.x; f[5] = b.y; f[6] = b.z; f[7] = b.w;
}
__device__ __forceinline__ void phase_features(KP p, int l) {
  const int tid_ = tidx(); const int bid_ = bidx(); (void)bid_;
  p = kp_launder(p);
  const u16* zrw = (const u16*)(p->ws + OFF_ZRW);
  const float* mu = p->in[9] + (size_t)l * RWC;
  const u16* lora = (const u16*)(p->ws + OFF_LORA) + (size_t)l * LORA_L;
  const u16* wupT = lora; const u16* aupT = lora + 98304; const u16* gupT = lora + 196608;
  const float* w0 = p->in[10] + (size_t)l * 2 * RW; const float* a0 = p->in[12] + (size_t)l * 2 * RW;
  const float* kk_ = p->in[15] + (size_t)l * RW; const float* ka_ = p->in[16] + (size_t)l * RW; const float* rk_ = p->in[17] + (size_t)l * RW;
  float* sb = (float*)(p->ws + OFF_SB);
  float* sbl = (float*)(smem + F_SB);
  const int lane = tid_ & 63, w = tid_ >> 6, fr = lane & 15, fq = lane >> 4;
  for (int it = bid_; it < MT / 16; it += gridDim.x) {
    const int R0 = it * 16;
    int s0, len, mr; seqinfo(R0, s0, len, mr);
    LDS_BARRIER();
    if (tid_ < 192) sbl[tid_] = 0.f;
#pragma unroll 9
    for (int i = 0; i < 9; ++i) {
      const int q = tid_ + 512 * i, tok = q / 288, grp = q % 288, sec = grp / 96, r = R0 + tok, col = grp * 8, ch = col - sec * RW;
      const bool hm = r - 1 >= s0, hp = r + 1 < s0 + len;
      const u16* z = zrw + (size_t)r * RWC + col;
      float c[8], a[8], b[8], o[8], m[8];
      unpack8(*(const uint4*)z, c);
      if (hm) unpack8(*(const uint4*)(z - RWC), a); else UFOR(x, 8) a[x] = 0.f;
      if (hp) unpack8(*(const uint4*)(z + RWC), b); else UFOR(x, 8) b[x] = 0.f;
      ld8f(mu + col, m);
      UFOR(x, 8) o[x] = c[x] + (0.5f * (a[x] + b[x]) - c[x]) * m[x];
      const uint4 pk = pack8(o);
      const size_t go = (size_t)r * RW + ch;
      if (sec == 0) { *(uint4*)(FA(0) + go) = pk; *(uint4*)(smem + F_RL + (tok * RW + ch) * 2) = pk; }
      else if (sec == 2) { *(uint4*)(FA(2) + go) = pk; }
      else {
        *(uint4*)(smem + F_KL + (tok * RW + ch) * 2) = pk;
        float kc[8], kq[8]; ld8f(kk_ + ch, kc);
        float ss = 0.f;
        UFOR(x, 8) { kq[x] = o[x] * kc[x]; ss += kq[x] * kq[x]; }
        ss += dppf<0xB1>(ss); ss += dppf<0x4E>(ss); ss += dppf<0x141>(ss);
        const float inv = 1.f / fmaxf(sqrtf(ss), 1e-12f);
        UFOR(x, 8) kq[x] *= inv;
        const uint4 pq = pack8(kq);
        *(uint4*)(FA(1) + go) = pq; *(uint4*)(smem + F_KK + (tok * RW + ch) * 2) = pq;
      }
    }
    {
      const int tok = tid_ >> 5, cg = tid_ & 31, r = R0 + tok;
      const bool hm = r - 1 >= s0, hp = r + 1 < s0 + len;
      const u16* z = zrw + (size_t)r * RWC + 2304 + cg * 8;
      float c[8], a[8], b[8], o[8], m[8];
      unpack8(*(const uint4*)z, c);
      if (hm) unpack8(*(const uint4*)(z - RWC), a); else UFOR(x, 8) a[x] = 0.f;
      if (hp) unpack8(*(const uint4*)(z + RWC), b); else UFOR(x, 8) b[x] = 0.f;
      ld8f(mu + 2304 + cg * 8, m);
      UFOR(x, 8) {
        const float v = c[x] + (0.5f * (a[x] + b[x]) - c[x]) * m[x];
        o[x] = (cg < 8) ? (1.f - 2.f / (1.f + __expf(2.f * v))) : ((cg < 16) ? v : sigmoidf_(v));
      }
      *(uint4*)(smem + F_AIN + tok * 528 + cg * 16) = pack8(o);
    }
    LDS_BARRIER();
    char* stg = smem + F_STG + w * 7168;
    for (int u = w * 3; u < w * 3 + 3; ++u) {
      const int hd = u >> 1, chb = hd * 64 + (u & 1) * 32;
      f32x4 aw0[2], aw1[2], aa0[2], aa1[2], ag[2];
      UFOR(n, 2) { aw0[n] = (f32x4){0.f, 0.f, 0.f, 0.f}; aw1[n] = aw0[n]; aa0[n] = aw0[n]; aa1[n] = aw0[n]; ag[n] = aw0[n]; }
      UFOR(ks, 2) {
        const bf16x8 atw = *(const bf16x8*)(smem + F_AIN + fr * 528 + (ks * 32 + fq * 8) * 2);
        const bf16x8 aad = *(const bf16x8*)(smem + F_AIN + fr * 528 + (64 + ks * 32 + fq * 8) * 2);
        UFOR(n, 2) {
          const int ch = chb + n * 16 + fr;
          aw0[n] = MFMA16(atw, *(const bf16x8*)(wupT + (size_t)ch * 64 + ks * 32 + fq * 8), aw0[n]);
          aw1[n] = MFMA16(atw, *(const bf16x8*)(wupT + (size_t)(RW + ch) * 64 + ks * 32 + fq * 8), aw1[n]);
          aa0[n] = MFMA16(aad, *(const bf16x8*)(aupT + (size_t)ch * 64 + ks * 32 + fq * 8), aa0[n]);
          aa1[n] = MFMA16(aad, *(const bf16x8*)(aupT + (size_t)(RW + ch) * 64 + ks * 32 + fq * 8), aa1[n]);
        }
      }
      UFOR(ks, 4) {
        const bf16x8 asg = *(const bf16x8*)(smem + F_AIN + fr * 528 + (128 + ks * 32 + fq * 8) * 2);
        UFOR(n, 2) {
          const int ch = chb + n * 16 + fr;
          ag[n] = MFMA16(asg, *(const bf16x8*)(gupT + (size_t)ch * 128 + ks * 32 + fq * 8), ag[n]);
        }
      }
      UFOR(n, 2) UFOR(j, 4) {
        const int e = (fq * 4 + j) * 32 + n * 16 + fr;
        ((float*)stg)[e] = aw0[n][j]; ((float*)(stg + 2048))[e] = aw1[n][j];
        ((u16*)(stg + 4096))[e] = f2bf(aa0[n][j]); ((u16*)(stg + 5120))[e] = f2bf(aa1[n][j]); ((u16*)(stg + 6144))[e] = f2bf(ag[n][j]);
      }
      asm volatile("s_waitcnt lgkmcnt(0)" ::: "memory");
      {
        const int tok = lane >> 2, g4 = lane & 3, ch = chb + g4 * 8, r = R0 + tok;
        float xw0[8], xw1[8], ya0[8], ya1[8], gg[8], kv[8], kkn[8], rr[8], cw0[8], cw1[8], ca0[8], ca1[8], cka[8], crk[8];
        ld8f((const float*)stg + tok * 32 + g4 * 8, xw0); ld8f((const float*)(stg + 2048) + tok * 32 + g4 * 8, xw1);
        unpack8(*(const uint4*)(stg + 4096 + (tok * 32 + g4 * 8) * 2), ya0); unpack8(*(const uint4*)(stg + 5120 + (tok * 32 + g4 * 8) * 2), ya1);
        unpack8(*(const uint4*)(stg + 6144 + (tok * 32 + g4 * 8) * 2), gg);
        unpack8(*(const uint4*)(smem + F_KL + (tok * RW + ch) * 2), kv); unpack8(*(const uint4*)(smem + F_KK + (tok * RW + ch) * 2), kkn);
        unpack8(*(const uint4*)(smem + F_RL + (tok * RW + ch) * 2), rr);
        ld8f(w0 + ch, cw0); ld8f(w0 + RW + ch, cw1); ld8f(a0 + ch, ca0); ld8f(a0 + RW + ch, ca1); ld8f(ka_ + ch, cka); ld8f(rk_ + ch, crk);
        float d0[8], d1[8], k0[8], k1[8], b0[8], b1[8];
        float bon = 0.f;
        UFOR(x, 8) {
          d0[x] = 0.6065306597126334f * sigmoidf_(cw0[x] + xw0[x]);
          d1[x] = 0.6065306597126334f * sigmoidf_(cw1[x] + xw1[x]);
          const float av0 = sigmoidf_(ca0[x] + ya0[x]), av1 = sigmoidf_(ca1[x] + ya1[x]);
          k0[x] = kv[x] * (1.f + (av0 - 1.f) * cka[x]); k1[x] = kv[x] * (1.f + (av1 - 1.f) * cka[x]);
          b0[x] = kkn[x] * av0; b1[x] = kkn[x] * av1;
          bon += rr[x] * 0.5f * (k0[x] + k1[x]) * crk[x];
        }
        const size_t go = (size_t)r * RW + ch;
        *(uint4*)(FA(3) + go) = packh8(d0); *(uint4*)(FA(4) + go) = packh8(d1);
        *(uint4*)(FA(5) + go) = pack8(k0); *(uint4*)(FA(6) + go) = pack8(k1);
        *(uint4*)(FA(7) + go) = pack8(b0); *(uint4*)(FA(8) + go) = pack8(b1);
        *(uint4*)(FA(9) + go) = pack8(gg);
        bon += dppf<0xB1>(bon); bon += dppf<0x4E>(bon);
        if (g4 == 0) atomicAdd(&sbl[tok * 12 + hd], bon);
      }
      asm volatile("s_waitcnt lgkmcnt(0)" ::: "memory");
    }
    LDS_BARRIER();
    if (tid_ < 192) sb[(size_t)(R0 + tid_ / 12) * 12 + (tid_ % 12)] = sbl[tid_];
  }
}

#define S_FEAT 0
#define S_V 81920
#define S_Y 86016
__device__ __forceinline__ int scan_row(int c, int s, int b, int dir) {
  if (c < 8) { const int ps = c * 32 + s; return ML + b * CTX + (dir ? (CTX - 1 - ps) : ps); }
  const int ps = (c - 8) * 32 + s; return b * TL + (dir ? (TL - 1 - ps) : ps);
}
__device__ __forceinline__ void phase_scan(KP p) {
  const int tid_ = tidx(); const int bid_ = bidx(); (void)bid_;
  p = kp_launder(p);
  const int tid = tid_, lane = tid & 63, w = tid >> 6;
  u16* Y = (u16*)(p->ws + OFF_Y);
  float* feat = (float*)(smem + S_FEAT);
  float* vbuf = (float*)(smem + S_V);
  float* ybuf = (float*)(smem + S_Y);
  const int NCH = 8 + TL / 32;
  for (int it = bid_; it < 192; it += gridDim.x) {
    const int rg = it & 3, dir = (it >> 2) & 1, bh = it >> 3, b = bh / 12, h = bh % 12;
    const u16* fr_ = FA(0); const u16* fkk = FA(1); const u16* fv = FA(2);
    const u16* fdw = FA(3 + dir); const u16* fkey = FA(5 + dir); const u16* fb = FA(7 + dir);
    u16* Yd = Y + (size_t)dir * MT * RW;
    f2 S01 = {0.f, 0.f}, S23 = {0.f, 0.f};
    const int rl = lane >> 4, cs = lane & 15;
    const int rowl = (w & 3) * 4 + rl;
    __syncthreads();
    const int pth = tid_ - 256, ppair = (pth >> 7) & 1, pt = pth & 127;
    uint4 rq[2][6];
    UFOR(x, 6) { rq[0][x] = make_uint4(0, 0, 0, 0); rq[1][x] = rq[0][x]; }
    if (w >= 4) {
      UFOR(e, 2) {
        const int q = pt + 128 * e, st = q >> 3, g8 = q & 7;
        const size_t o = (size_t)scan_row(ppair, st, b, dir) * RW + h * 64 + g8 * 8;
        rq[e][0] = *(const uint4*)(fr_ + o); rq[e][1] = *(const uint4*)(fdw + o); rq[e][2] = *(const uint4*)(fkey + o);
        rq[e][3] = *(const uint4*)(fkk + o); rq[e][4] = *(const uint4*)(fb + o); rq[e][5] = *(const uint4*)(fv + o);
      }
    }
    for (int c = -1; c < NCH; ++c) {
      if (w >= 4) {
        if (((c + 1) & 1) == ppair) {
          if (c + 1 < NCH) {
            const int buf = (c + 1) & 1;
            UFOR(e, 2) {
              const int q = pt + 128 * e, st = q >> 3, g8 = q & 7;
              float f[8];
              float* fd = feat + ((buf * 32 + st) * 5) * 64 + g8 * 8;
              unpack8(rq[e][0], f); *(float4*)(fd) = make_float4(f[0], f[1], f[2], f[3]); *(float4*)(fd + 4) = make_float4(f[4], f[5], f[6], f[7]);
              { const uint4 u = rq[e][1];
                f[0] = h2f((u16)(u.x & 0xffff)); f[1] = h2f((u16)(u.x >> 16)); f[2] = h2f((u16)(u.y & 0xffff)); f[3] = h2f((u16)(u.y >> 16));
                f[4] = h2f((u16)(u.z & 0xffff)); f[5] = h2f((u16)(u.z >> 16)); f[6] = h2f((u16)(u.w & 0xffff)); f[7] = h2f((u16)(u.w >> 16));
                UFOR(x, 8) f[x] = __expf(-f[x]);
                *(float4*)(fd + 64) = make_float4(f[0], f[1], f[2], f[3]); *(float4*)(fd + 68) = make_float4(f[4], f[5], f[6], f[7]); }
              unpack8(rq[e][2], f); *(float4*)(fd + 128) = make_float4(f[0], f[1], f[2], f[3]); *(float4*)(fd + 132) = make_float4(f[4], f[5], f[6], f[7]);
              unpack8(rq[e][3], f); *(float4*)(fd + 192) = make_float4(-f[0], -f[1], -f[2], -f[3]); *(float4*)(fd + 196) = make_float4(-f[4], -f[5], -f[6], -f[7]);
              unpack8(rq[e][4], f); *(float4*)(fd + 256) = make_float4(f[0], f[1], f[2], f[3]); *(float4*)(fd + 260) = make_float4(f[4], f[5], f[6], f[7]);
              if ((g8 >> 1) == rg) {
                unpack8(rq[e][5], f);
                float* vd = vbuf + (buf * 16 + (g8 & 1) * 8) * 32 + st;
                UFOR(x, 8) vd[x * 32] = f[x];
              }
            }
          }
          if (c + 3 < NCH) {
            UFOR(e, 2) {
              const int q = pt + 128 * e, st = q >> 3, g8 = q & 7;
              const size_t o = (size_t)scan_row(c + 3, st, b, dir) * RW + h * 64 + g8 * 8;
              rq[e][0] = *(const uint4*)(fr_ + o); rq[e][1] = *(const uint4*)(fdw + o); rq[e][2] = *(const uint4*)(fkey + o);
              rq[e][3] = *(const uint4*)(fkk + o); rq[e][4] = *(const uint4*)(fb + o); rq[e][5] = *(const uint4*)(fv + o);
            }
          }
        } else if (c >= 1) {
          const int buf = (c - 1) & 1;
          UFOR(e, 4) {
            const int q = pt + 128 * e, st = q >> 4, rw = q & 15;
            Yd[(size_t)scan_row(c - 1, st, b, dir) * RW + h * 64 + rg * 16 + rw] = f2bf(ybuf[(buf * 32 + st) * 16 + rw]);
          }
        }
      } else if (c >= 0) {
        const int buf = c & 1;
        const float* fbase = feat + (buf * 32) * 320 + cs * 4;
        const float* vb4 = vbuf + (buf * 16 + rowl) * 32;
        const bool b3 = (cs & 8) != 0, b2 = (cs & 4) != 0;
        float* yb = ybuf + (buf * 32 + (b3 ? 2 : 0) + (b2 ? 1 : 0)) * 16 + rowl;
        float4 Ar, Aw, Ak, An, Ab, Br, Bw, Bk, Bn, Bb, Cr, Cw, Ck, Cn, Cb, Dr, Dw, Dk, Dn, Db;
        float4 vcur = *(const float4*)vb4, vnext;
        float q0 = 0.f, q1 = 0.f, q2 = 0.f, q3 = 0.f, p0 = 0.f, p1 = 0.f, p2 = 0.f, p3 = 0.f;
#define SLD(R, st_) { const float* fd = fbase + (st_) * 320; R##r = *(const float4*)fd; R##w = *(const float4*)(fd + 64); R##k = *(const float4*)(fd + 128); \
                      R##n = *(const float4*)(fd + 192); R##b = *(const float4*)(fd + 256); }
#define SCOMP(R, VV, QQ) { \
          f2 p = S01 * (f2){R##n.x, R##n.y}; p = S23 * (f2){R##n.z, R##n.w} + p; \
          float sa = red16(p.x + p.y); \
          f2 u01 = (f2){R##k.x, R##k.y} * (VV); u01 = S01 * (f2){R##w.x, R##w.y} + u01; \
          f2 u23 = (f2){R##k.z, R##k.w} * (VV); u23 = S23 * (f2){R##w.z, R##w.w} + u23; \
          S01 = (f2){R##b.x, R##b.y} * sa + u01; S23 = (f2){R##b.z, R##b.w} * sa + u23; \
          f2 q = S01 * (f2){R##r.x, R##r.y}; q = S23 * (f2){R##r.z, R##r.w} + q; \
          QQ = q.x + q.y; }
#define YRED4(dst) { \
          float a0 = b3 ? p2 : p0, a1 = b3 ? p3 : p1; const float s0 = b3 ? p0 : p2, s1 = b3 ? p1 : p3; \
          a0 += dppf<0x128>(s0); a1 += dppf<0x128>(s1); \
          float cc = b2 ? a1 : a0; const float dd = b2 ? a0 : a1; \
          cc += dppf<0x141>(dd); cc += dppf<0xB1>(cc); cc += dppf<0x4E>(cc); dst = cc; }
        SLD(A, 0); SLD(B, 1);
        for (int g = 0; g < 8; ++g) {
          const int st = g * 4;
          SLD(C, st + 2); vnext = *(const float4*)(vb4 + st + 4);
          __builtin_amdgcn_sched_barrier(0);
          if (g > 0) { float yv; YRED4(yv); yb[(st - 4) * 16] = yv; }
          SCOMP(A, vcur.x, q0);
          SLD(D, st + 3);
          __builtin_amdgcn_sched_barrier(0);
          SCOMP(B, vcur.y, q1);
          SLD(A, st + 4);
          __builtin_amdgcn_sched_barrier(0);
          SCOMP(C, vcur.z, q2);
          SLD(B, st + 5);
          __builtin_amdgcn_sched_barrier(0);
          SCOMP(D, vcur.w, q3);
          vcur = vnext; p0 = q0; p1 = q1; p2 = q2; p3 = q3;
        }
        { float yv; YRED4(yv); yb[28 * 16] = yv; }
#undef SLD
#undef SCOMP
#undef YRED4
      }
      asm volatile("s_waitcnt lgkmcnt(0)" ::: "memory");
      __builtin_amdgcn_s_barrier();
      asm volatile("" ::: "memory");
    }
    if (w >= 4) {
      const int buf = (NCH - 1) & 1;
      for (int q = pth; q < 512; q += 256) {
        const int st = q >> 4, rw = q & 15;
        Yd[(size_t)scan_row(NCH - 1, st, b, dir) * RW + h * 64 + rg * 16 + rw] = f2bf(ybuf[(buf * 32 + st) * 16 + rw]);
      }
    }
    __syncthreads();
  }
}

__device__ __forceinline__ void phase_rwkv_out(KP p, int l, int nrows) {
  const int tid_ = tidx(); const int bid_ = bidx(); (void)bid_;
  p = kp_launder(p);
  const u16* Y = (const u16*)(p->ws + OFF_Y);
  const float* sb = (const float*)(p->ws + OFF_SB);
  u16* mix = (u16*)(p->ws + OFF_A);
  const float* lg = p->in[18] + (size_t)l * RW; const float* lb = p->in[19] + (size_t)l * RW;
  const int lane = tid_ & 63, w = tid_ >> 6;
  for (int r = bid_ * 8 + w; r < nrows; r += gridDim.x * 8) {
    uint2 yf[3], yb[3], vv[3], gg[3]; float sbv[3];
    UFOR(j, 3) {
      const size_t o = (size_t)r * RW + j * 256 + lane * 4;
      yf[j] = *(const uint2*)(Y + o); yb[j] = *(const uint2*)(Y + (size_t)MT * RW + o);
      vv[j] = *(const uint2*)(FA(2) + o); gg[j] = *(const uint2*)(FA(9) + o);
      sbv[j] = sb[(size_t)r * 12 + j * 4 + (lane >> 4)];
    }
    UFOR(j, 3) {
      const int c = j * 256 + lane * 4;
      float y[4] = {lo2f(yf[j].x) + lo2f(yb[j].x), hi2f(yf[j].x) + hi2f(yb[j].x), lo2f(yf[j].y) + lo2f(yb[j].y), hi2f(yf[j].y) + hi2f(yb[j].y)};
      const float mu = red16((y[0] + y[1]) + (y[2] + y[3])) * (1.f / 64.f);
      UFOR(x, 4) y[x] -= mu;
      const float var = red16((y[0] * y[0] + y[1] * y[1]) + (y[2] * y[2] + y[3] * y[3])) * (1.f / 64.f);
      const float rstd = rsqrtf(var + 64e-5f);
      const float4 lgv = *(const float4*)(lg + c), lbv = *(const float4*)(lb + c);
      const float v[4] = {lo2f(vv[j].x), hi2f(vv[j].x), lo2f(vv[j].y), hi2f(vv[j].y)};
      const float g[4] = {lo2f(gg[j].x), hi2f(gg[j].x), lo2f(gg[j].y), hi2f(gg[j].y)};
      const float o0 = (y[0] * rstd * lgv.x + lbv.x + sbv[j] * v[0]) * g[0];
      const float o1 = (y[1] * rstd * lgv.y + lbv.y + sbv[j] * v[1]) * g[1];
      const float o2 = (y[2] * rstd * lgv.z + lbv.z + sbv[j] * v[2]) * g[2];
      const float o3 = (y[3] * rstd * lgv.w + lbv.w + sbv[j] * v[3]) * g[3];
      uint2 pk; pk.x = pk2(o0, o1); pk.y = pk2(o2, o3);
      *(uint2*)(mix + (size_t)r * DM + c) = pk;
    }
  }
}


#define XB_TMO      128
#define XB_XCNT(j)  (256  + 64 * (j))
#define XB_XSUB(j)  (1280 + 64 * (j))
#define XB_XGEN(j)  (2304 + 64 * (j))
#define XB_TOP      3328
#define XB_TOPGEN   3392
#define XCD_BAR_WORDS 3456
#define XB_SPIN_CAP (1u << 18)
#define LAS __attribute__((address_space(3)))
__device__ __forceinline__ unsigned xb_ld(unsigned* p)              { return __hip_atomic_load(p, __ATOMIC_RELAXED, __HIP_MEMORY_SCOPE_AGENT); }
__device__ __forceinline__ unsigned xb_add(unsigned* p, unsigned v) { return __hip_atomic_fetch_add(p, v, __ATOMIC_RELAXED, __HIP_MEMORY_SCOPE_AGENT); }
__device__ __forceinline__ unsigned xb_xcc_id() { return (unsigned)__builtin_amdgcn_s_getreg((3 << 11) | 20) & 0xFu; }
#define XB_SPIN(cond, bar) do { unsigned _sp = 0; while (cond) { __builtin_amdgcn_s_sleep(1); \
    if ((++_sp & 255u) == 0u) { if (xb_ld(&(bar)[XB_TMO])) break; if (_sp > XB_SPIN_CAP) { atomicAdd(&(bar)[XB_TMO], 1u); break; } } } } while (0)
struct XcdBarrier { unsigned* bar; unsigned x; volatile LAS unsigned* st; };
__device__ __forceinline__ XcdBarrier xcd_barrier_post(unsigned* bar, volatile LAS unsigned* st) {
    XcdBarrier b; b.bar = bar; b.x = xb_xcc_id(); b.st = st;
    if (threadIdx.x == 0) (void)xb_add(&bar[XB_XCNT(b.x)], 1u);
    return b;
}
__device__ __forceinline__ void xcd_barrier_complete(unsigned* bar, unsigned x, unsigned& nloc, unsigned& nx) {
    const unsigned G = gridDim.x * gridDim.y * gridDim.z;
    unsigned sum, cnt, mine, sp = 0u;
    for (;;) {
        sum = 0u; cnt = 0u; mine = 0u;
#pragma unroll
        for (unsigned j = 0; j < 16; ++j) { const unsigned c = xb_ld(&bar[XB_XCNT(j)]); sum += c; cnt += (c > 0u) ? 1u : 0u; mine = (j == x) ? c : mine; }
        if (sum == G) break;
        __builtin_amdgcn_s_sleep(1);
        if ((++sp & 255u) == 0u) { if (xb_ld(&bar[XB_TMO])) break; if (sp > XB_SPIN_CAP) { atomicAdd(&bar[XB_TMO], 1u); break; } }
    }
    nloc = mine > 0u ? mine : 1u; nx = cnt > 0u ? cnt : 1u;
}
__device__ __forceinline__ void xcd_barrier(const XcdBarrier& b) {
    asm volatile("s_waitcnt vmcnt(0)" ::: "memory");
    __syncthreads();
    if (threadIdx.x == 0) {
        unsigned* bar = b.bar;
        __builtin_amdgcn_s_waitcnt(0);
        unsigned nloc = b.st[0], nx = b.st[1];
        if (nloc == 0u) { xcd_barrier_complete(bar, b.x, nloc, nx); b.st[0] = nloc; b.st[1] = nx; }
        const unsigned old = xb_add(&bar[XB_XSUB(b.x)], 1u);
        const unsigned gen = old / nloc;
        if (old + 1u == (gen + 1u) * nloc) {
            __builtin_amdgcn_fence(__ATOMIC_RELEASE, "agent");
            asm volatile("s_waitcnt vmcnt(0)" ::: "memory");
            const unsigned og = xb_add(&bar[XB_TOP], 1u);
            const unsigned tg = og / nx;
            if (og + 1u == (tg + 1u) * nx) xb_add(&bar[XB_TOPGEN], 1u);
            else XB_SPIN(xb_ld(&bar[XB_TOPGEN]) == tg, bar);
            __builtin_amdgcn_fence(__ATOMIC_ACQUIRE, "agent");
            xb_add(&bar[XB_XGEN(b.x)], 1u);
            asm volatile("s_waitcnt vmcnt(0)" ::: "memory");
        } else {
            XB_SPIN(xb_ld(&bar[XB_XGEN(b.x)]) == gen, bar);
            __builtin_amdgcn_fence(__ATOMIC_ACQUIRE, "agent");
            asm volatile("s_waitcnt vmcnt(0)" ::: "memory");
        }
    }
    __syncthreads();
}

#ifndef REP_SCAN
#define REP_SCAN 1
#endif
#ifndef REP_FEAT
#define REP_FEAT 1
#endif
#ifndef REP_R3
#define REP_R3 1
#endif
#ifndef REP_ROUT
#define REP_ROUT 1
#endif
#ifndef REP_GIN
#define REP_GIN 1
#endif
__global__ void __launch_bounds__(NTHREADS) fwd_kernel(Params pk_unused, int ph_lo, int ph_hi, int use_sync) {
  KP p = (KP)__builtin_amdgcn_kernarg_segment_ptr();
  cg::grid_group grid = cg::this_grid();
  volatile LAS unsigned* xst = (volatile LAS unsigned*)(smem + LDS_BYTES - 16);
  if (threadIdx.x == 0) { xst[0] = 0u; xst[1] = 0u; xst[2] = 0u; xst[3] = 0u; }
  __syncthreads();
  XcdBarrier xb = xcd_barrier_post((unsigned*)(p->ws + OFF_BAR), xst);
  int ph = 0;
#define PHASE_BEGIN if (ph >= ph_lo && ph < ph_hi) {
#define PHASE_END } if (use_sync && ph >= ph_lo && ph + 1 < ph_hi) { if (ph == 0) grid.sync(); else xcd_barrier(xb); } ++ph;
  const float* mods = (const float*)(p->ws + OFF_MODS);
  PHASE_BEGIN
    phase_mods(p);
    __syncthreads();
    convert_win(p, 0, 0, gridDim.x);
    convert_wout(p, 0, 0, gridDim.x);
    phase_misc0(p);
  PHASE_END
  for (int l = 0; l < 2; ++l) {
    const float* modl = mods + (size_t)l * 3 * 12288;
    PHASE_BEGIN
      phase_norm(p, l, 0, MT);
    PHASE_END
    PHASE_BEGIN
      EpiArgs e{}; e.zrw = (u16*)(p->ws + OFF_ZRW); e.zcr = (u16*)(p->ws + OFF_ZCR);
      for (int rep = 0; rep < REP_GIN; ++rep) gemm_phase<EPI_Z, DM>((const u16*)(p->ws + OFF_A), (const u16*)(p->ws + OFF_WIN), MT / 256, INC / 256, e);
    PHASE_END
    PHASE_BEGIN
      phase_ret_summaries(p);
      __syncthreads();
      phase_convmix(p, l, l == 1 ? ML : MT);
    PHASE_END
    PHASE_BEGIN
      for (int rep = 0; rep < REP_R3; ++rep) phase_ret_out(p, l, l == 0);
    PHASE_END
    PHASE_BEGIN
      for (int rep = 0; rep < REP_FEAT; ++rep) phase_features(p, l);
    PHASE_END
    PHASE_BEGIN
      phase_scan(p);
      {
        const int cf = gridDim.x > 192 ? 192 : 0, cs_ = gridDim.x > 192 ? (int)gridDim.x - 192 : (int)gridDim.x;
        __syncthreads();
        convert_ffn(p, l, cf, cs_);
        if (l == 0) convert_win(p, 1, cf, cs_);
      }
    PHASE_END
    PHASE_BEGIN
      for (int rep = 0; rep < REP_ROUT; ++rep) phase_rwkv_out(p, l, l == 1 ? ML : MT);
    PHASE_END
    PHASE_BEGIN
      EpiArgs e{};
      e.srcL = (l == 0) ? p->in[0] : p->out; e.srcC = (l == 0) ? p->in[2] : (const float*)(p->ws + OFF_XC);
      e.dstL = p->out; e.dstC = (float*)(p->ws + OFF_XC); e.gate = modl + 2 * DM;
      gemm_phase<EPI_RES, DM>((const u16*)(p->ws + OFF_A), (const u16*)(p->ws + OFF_WOUT), l == 1 ? 128 : 130, DM / 256, e);
    PHASE_END
    PHASE_BEGIN
      phase_norm(p, l, 1, l == 1 ? ML : MT);
      if (l == 0) { __syncthreads(); convert_wout(p, 1, 0, gridDim.x); }
    PHASE_END
    PHASE_BEGIN
      EpiArgs e{}; e.h2 = (u16*)(p->ws + OFF_H2); e.cw = p->in[24] + (size_t)l * 2 * DFF * 3;
      gemm_phase<EPI_UPG, DM>((const u16*)(p->ws + OFF_A), (const u16*)(p->ws + OFF_WUP), l == 1 ? 130 : 132, DFF / 128, e);
    PHASE_END
    PHASE_BEGIN
      EpiArgs e{};
      e.srcL = p->out; e.srcC = (const float*)(p->ws + OFF_XC); e.dstL = p->out; e.dstC = (float*)(p->ws + OFF_XC); e.gate = modl + 5 * DM;
      gemm_phase<EPI_RES, DFF>((const u16*)(p->ws + OFF_H2), (const u16*)(p->ws + OFF_WDN), 128, DM / 256, e);
      if (l == 0) gemm_ctx_splitk_down((const u16*)(p->ws + OFF_H2), (const u16*)(p->ws + OFF_WDN), (float*)(p->ws + OFF_P2), e);
    PHASE_END
  }
  PHASE_BEGIN
    phase_final(p);
  PHASE_END
}

#define NPHASES 24

extern "C" void kernel_launch(void* const* d_in, const int* in_sizes, int n_in, void* d_out, int out_size, void* d_ws, size_t ws_size,
                              hipStream_t stream) {
  static int grid = 0;
  if (grid == 0) {
    int dev = 0, cus = 0, per_cu = 0;
    hipGetDevice(&dev);
    hipDeviceGetAttribute(&cus, hipDeviceAttributeMultiprocessorCount, dev);
    hipFuncSetAttribute((const void*)fwd_kernel, hipFuncAttributeMaxDynamicSharedMemorySize, LDS_BYTES);
    hipOccupancyMaxActiveBlocksPerMultiprocessor(&per_cu, (const void*)fwd_kernel, NTHREADS, LDS_BYTES);
    (void)hipGetLastError();
    if (per_cu < 1) per_cu = 1;
    grid = cus;
    if (ws_size < 952 * MIB) fprintf(stderr, "kernel_launch: workspace too small: %zu\n", ws_size);
  }
  if (hipMemsetAsync((char*)d_ws + OFF_BAR, 0, 16384, stream) != hipSuccess) fprintf(stderr, "kernel_launch: memset of barrier words failed\n");
  Params p{};
  UFOR(i, 27) p.in[i] = (const float*)d_in[i];
  p.out = (float*)d_out;
  p.ws = (char*)d_ws;
  int lo = 0, hi = NPHASES, us = 1;
  void* args[] = {&p, &lo, &hi, &us};
  hipError_t e = hipLaunchCooperativeKernel((const void*)fwd_kernel, dim3(grid), dim3(NTHREADS), args, LDS_BYTES, stream);
  if (e != hipSuccess) fprintf(stderr, "cooperative launch failed: %s (grid %d)\n", hipGetErrorString(e), grid);
}
```
